# Optimizing an MI355X kernel written in HIP

```python
import math
import jax, jax.numpy as jnp
from jax import lax
import numpy as np

D_MODEL = 1024
BATCH = 1
SEQ = 16384
DEPTH = 1

FOX_HEAD_DIM = 64
FOX_HEADS = (D_MODEL // 2) // FOX_HEAD_DIM
FOX_WIDTH = FOX_HEADS * FOX_HEAD_DIM
RET_HEAD_DIM = 128
RET_HEADS = (D_MODEL - FOX_WIDTH) // RET_HEAD_DIM
RET_WIDTH = RET_HEADS * RET_HEAD_DIM
MIX_WIDTH = FOX_WIDTH + RET_WIDTH
D_FF = 256 * int(math.ceil(8 * D_MODEL / 3 / 256))
CONV_WIDTH = 3
Q_BLOCK = 128
RET_CHUNK = 128
ROPE_BASE = 10000.0
LN_EPS = 1e-5
GN_EPS = 1e-6
ALPHA = (2 * DEPTH) ** 0.25
BETA = (8 * DEPTH) ** -0.25
IN_SIZES = [FOX_WIDTH, FOX_WIDTH, FOX_WIDTH, FOX_HEADS,
            RET_WIDTH, RET_WIDTH, RET_WIDTH, RET_WIDTH]
IN_COLS = sum(IN_SIZES)
IN_SPLITS = [int(v) for v in np.cumsum(IN_SIZES)[:-1]]

kernel_name = "fox_retnet_hymba_deepnorm_adaln_layer"


def layer_norm(x, g, b):
    xf = x.astype(jnp.float32)
    mu = jnp.mean(xf, axis=-1, keepdims=True)
    var = jnp.mean(jnp.square(xf - mu), axis=-1, keepdims=True)
    y = (xf - mu) * lax.rsqrt(var + LN_EPS)
    return (y * g + b).astype(x.dtype)


def forgetting_attention(q, k, v, log_f):
    B, S, H, Dh = q.shape
    nb = S // Q_BLOCK
    scale = Dh ** -0.5
    cum = jnp.cumsum(log_f.astype(jnp.float32), axis=1).transpose(0, 2, 1)
    kh = k.transpose(0, 2, 1, 3)
    vh = v.transpose(0, 2, 1, 3)
    qb = q.reshape(B, nb, Q_BLOCK, H, Dh).transpose(1, 0, 3, 2, 4)
    cb = cum.reshape(B, H, nb, Q_BLOCK).transpose(2, 0, 1, 3)
    key_pos = jnp.arange(S)

    def block(args):
        qi, ci, start = args
        s = jnp.einsum('bhqd,bhkd->bhqk', qi, kh,
                       preferred_element_type=jnp.float32) * scale
        s = s + ci[..., None] - cum[:, :, None, :]
        q_pos = start + jnp.arange(Q_BLOCK)
        s = jnp.where(key_pos[None, :] <= q_pos[:, None], s, -jnp.inf)
        p = jax.nn.softmax(s, axis=-1)
        return jnp.einsum('bhqk,bhkd->bhqd', p.astype(vh.dtype), vh)

    out = lax.map(block, (qb, cb, jnp.arange(nb) * Q_BLOCK))
    return out.transpose(1, 0, 3, 2, 4).reshape(B, S, H * Dh)


def rotate_half(x):
    x1, x2 = jnp.split(x, 2, axis=-1)
    return jnp.concatenate([-x2, x1], axis=-1)


def retention(q, k, v, g):
    B, S, H, dk = q.shape
    dv = v.shape[-1]
    C = RET_CHUNK
    nc = S // C
    dt = q.dtype
    pos = jnp.arange(S, dtype=jnp.float32)
    inv_freq = ROPE_BASE ** (-jnp.arange(0, dk, 2, dtype=jnp.float32) / dk)
    ang = pos[:, None] * inv_freq[None, :]
    ang = jnp.concatenate([ang, ang], axis=-1)
    cos = jnp.cos(ang)[None, :, None, :].astype(dt)
    sin = jnp.sin(ang)[None, :, None, :].astype(dt)
    q = q * cos + rotate_half(q) * sin
    k = (k * cos + rotate_half(k) * sin) * (dk ** -0.5)
    log_gamma = jnp.log1p(-jnp.exp2(-5.0 - jnp.arange(H, dtype=jnp.float32)))
    idx = jnp.arange(C, dtype=jnp.float32)
    diff = idx[:, None] - idx[None, :]
    inner = jnp.where(diff[None] >= 0,
                      jnp.exp(jnp.maximum(diff, 0.0)[None] * log_gamma[:, None, None]),
                      0.0).astype(dt)
    xi = jnp.exp((idx[None, :] + 1.0) * log_gamma[:, None]).astype(dt)
    zeta = jnp.exp((C - 1.0 - idx[None, :]) * log_gamma[:, None]).astype(dt)
    g_chunk = jnp.exp(C * log_gamma).astype(dt)

    def to_chunks(t):
        return t.reshape(B, nc, C, H, t.shape[-1]).transpose(1, 0, 3, 2, 4)

    qc, kc, vc = to_chunks(q), to_chunks(k), to_chunks(v)

    def step(R, xs):
        qi, ki, vi = xs
        s = jnp.einsum('bhnd,bhmd->bhnm', qi, ki) * inner[None]
        o = (jnp.einsum('bhnm,bhmv->bhnv', s, vi)
             + jnp.einsum('bhnd,bhdv->bhnv', qi, R) * xi[None, :, :, None])
        R = (R * g_chunk[None, :, None, None]
             + jnp.einsum('bhmd,bhmv->bhdv', ki * zeta[None, :, :, None], vi))
        return R, o

    R0 = jnp.zeros((B, H, dk, dv), dt)
    _, o = lax.scan(step, R0, (qc, kc, vc))
    o = o.transpose(1, 0, 3, 2, 4).reshape(B, S, H, dv)
    of = o.astype(jnp.float32)
    mu = jnp.mean(of, axis=-1, keepdims=True)
    var = jnp.mean(jnp.square(of - mu), axis=-1, keepdims=True)
    o = ((of - mu) * lax.rsqrt(var + GN_EPS)).astype(dt).reshape(B, S, H * dv)
    return jax.nn.silu(g) * o


def causal_depthwise_conv(u, w, b):
    S = u.shape[1]
    up = jnp.pad(u, ((0, 0), (CONV_WIDTH - 1, 0), (0, 0)))
    y = b
    for i in range(CONV_WIDTH):
        y = y + up[:, i:i + S, :] * w[i]
    return y


def setup_inputs(seed: int = 0) -> dict:
    key = jax.random.key(seed)
    ks = jax.random.split(key, 16)
    f32 = jnp.float32
    x = jax.random.normal(ks[0], (BATCH, SEQ, D_MODEL), f32)
    c = jax.random.normal(ks[1], (BATCH, D_MODEL), f32)
    w_ada = jax.random.normal(ks[2], (DEPTH, D_MODEL, 6 * D_MODEL), f32) * D_MODEL ** -0.5
    b_ada = 0.01 * jax.random.normal(ks[3], (DEPTH, 6 * D_MODEL), f32)
    col_scale = np.ones((IN_COLS,), np.float32)
    fv0 = 2 * FOX_WIDTH
    col_scale[fv0:fv0 + FOX_WIDTH] = BETA
    rv0 = 3 * FOX_WIDTH + FOX_HEADS + 2 * RET_WIDTH
    col_scale[rv0:rv0 + RET_WIDTH] = BETA
    w_in = (jax.random.normal(ks[4], (DEPTH, D_MODEL, IN_COLS), f32)
            * D_MODEL ** -0.5 * jnp.asarray(col_scale))
    b_f = 2.0 + 0.1 * jax.random.normal(ks[5], (DEPTH, FOX_HEADS), f32)
    w_out = jax.random.normal(ks[6], (DEPTH, MIX_WIDTH, D_MODEL), f32) * MIX_WIDTH ** -0.5 * BETA
    ln1_g = 1.0 + 0.02 * jax.random.normal(ks[7], (DEPTH, D_MODEL), f32)
    ln1_b = 0.02 * jax.random.normal(ks[8], (DEPTH, D_MODEL), f32)
    w_up = jax.random.normal(ks[9], (DEPTH, D_MODEL, 2 * D_FF), f32) * D_MODEL ** -0.5 * BETA
    conv_w = jax.random.normal(ks[10], (DEPTH, CONV_WIDTH, 2 * D_FF), f32) * CONV_WIDTH ** -0.5
    conv_b = 0.02 * jax.random.normal(ks[11], (DEPTH, 2 * D_FF), f32)
    w_down = jax.random.normal(ks[12], (DEPTH, D_FF, D_MODEL), f32) * D_FF ** -0.5 * BETA
    ln2_g = 1.0 + 0.02 * jax.random.normal(ks[13], (DEPTH, D_MODEL), f32)
    ln2_b = 0.02 * jax.random.normal(ks[14], (DEPTH, D_MODEL), f32)
    return {"x": x, "c": c, "w_ada": w_ada, "b_ada": b_ada, "w_in": w_in,
            "b_f": b_f, "w_out": w_out, "ln1_g": ln1_g, "ln1_b": ln1_b,
            "w_up": w_up, "conv_w": conv_w, "conv_b": conv_b, "w_down": w_down,
            "ln2_g": ln2_g, "ln2_b": ln2_b}


def reference(x, c, w_ada, b_ada, w_in, b_f, w_out, ln1_g, ln1_b,
              w_up, conv_w, conv_b, w_down, ln2_g, ln2_b):
    B, S, D = x.shape
    for l in range(DEPTH):
        mod = jax.nn.silu(c) @ w_ada[l] + b_ada[l]
        sh1, sc1, g1, sh2, sc2, g2 = jnp.split(mod[:, None, :], 6, axis=-1)
        h = x * (1.0 + sc1) + sh1
        proj = h @ w_in[l]
        fq, fk, fv, ff, rq, rk, rv, rg = jnp.split(proj, IN_SPLITS, axis=-1)
        log_f = jax.nn.log_sigmoid(ff + b_f[l])
        fox = forgetting_attention(
            fq.reshape(B, S, FOX_HEADS, FOX_HEAD_DIM),
            fk.reshape(B, S, FOX_HEADS, FOX_HEAD_DIM),
            fv.reshape(B, S, FOX_HEADS, FOX_HEAD_DIM), log_f)
        ret = retention(
            rq.reshape(B, S, RET_HEADS, RET_HEAD_DIM),
            rk.reshape(B, S, RET_HEADS, RET_HEAD_DIM),
            rv.reshape(B, S, RET_HEADS, RET_HEAD_DIM), rg)
        mix = jnp.concatenate([fox, ret], axis=-1) @ w_out[l]
        x = layer_norm(ALPHA * x + g1 * mix, ln1_g[l], ln1_b[l])
        h = x * (1.0 + sc2) + sh2
        u = causal_depthwise_conv(h @ w_up[l], conv_w[l], conv_b[l])
        a, bv = jnp.split(u, 2, axis=-1)
        y = (jax.nn.gelu(a, approximate=False) * bv) @ w_down[l]
        x = layer_norm(ALPHA * x + g2 * y, ln2_g[l], ln2_b[l])
    return x
```

```cpp
#include <hip/hip_runtime.h>
#include <hip/hip_cooperative_groups.h>
#include <cstdio>
#include <cstdint>
namespace cg = cooperative_groups;
namespace pg8 {
#define PG8_LAS __attribute__((address_space(3)))
typedef unsigned short bf16_t;
typedef short bf16x8 __attribute__((ext_vector_type(8)));
typedef float f32x4 __attribute__((ext_vector_type(4)));
typedef unsigned u32x4 __attribute__((ext_vector_type(4)));
constexpr int BM = 256, BK = 64, HALF = 128, HTB = HALF * BK * 2  , STAGE_BYTES = 8 * HTB, NXCD = 8, WGM = 8;

__host__ __device__ __forceinline__ int lds_byte(int r, int c) { const int st = (r >> 4) * 2 + (c >> 5), rr = r & 15, cc = c & 31, ob = rr * 64 + cc * 2; return st * 1024 + (ob ^ (((ob >> 9) & 1) << 5)); }
__host__ __device__ __forceinline__ void stage_rc(int b, int& R, int& C) { const int st = b / 1024, sb = b % 1024, swz = sb ^ (((sb >> 9) & 1) << 5); R = (st >> 1) * 16 + swz / 64; C = (st & 1) * 32 + (swz % 64) / 2; }
__host__ __device__ __forceinline__ int perm32(int rho) { const int n = rho >> 4, i = rho & 15; return 8 * (i >> 2) + 4 * n + (i & 3); }

struct Unit { int pm, pn; };
struct Gemm { const bf16_t* A; const bf16_t* Bt; int M, N, K; int arows; };

struct StaticOrder {
    int nM, nN, nwg, G, c;
    __host__ __device__ void init(int M, int N, int G_, int c_) { nM = M / BM; nN = N / BM; nwg = nM * nN; G = G_; c = c_; }
    __host__ __device__ bool next(int i, Unit& u) const {
        const long L = (long)i * G + c; if (L >= nwg) return false;
        int wgid = (int)L; { const int q = nwg / NXCD, r = nwg % NXCD, xcd = wgid % NXCD, off = wgid / NXCD; wgid = (xcd < r ? xcd * (q + 1) : r * (q + 1) + (xcd - r) * q) + off; }
        const int nig = WGM * nN, gid = wgid / nig, fm = gid * WGM, gsz = (nM - fm) < WGM ? (nM - fm) : WGM;
        u.pm = fm + ((wgid % nig) % gsz); u.pn = (wgid % nig) / gsz; return true;
    }
    __device__ __forceinline__ void a_ready(const Unit&) const {}
    __device__ __forceinline__ void done(const Unit&) const {}
};

__device__ __forceinline__ unsigned cvt_pk_bf16(float lo, float hi) { unsigned r; asm volatile("v_cvt_pk_bf16_f32 %0, %1, %2" : "=v"(r) : "v"(lo), "v"(hi)); return r; }
typedef float f32x2 __attribute__((ext_vector_type(2)));
__device__ __forceinline__ f32x2 gelu_pk(f32x2 v) {
    const f32x2 av = __builtin_elementwise_abs(v), d = av * 0.2316418882f + 1.0f;
    f32x2 t; t.x = __builtin_amdgcn_rcpf(d.x); t.y = __builtin_amdgcn_rcpf(d.y);
    f32x2 q = t * 0.5307027145f + (-0.7265760135f); q = q * t + 0.7107068705f; q = q * t + (-0.142248368f); q = q * t + 0.127414796f; q = q * t;
    const f32x2 s = (v * v) * (-0.72134752044f);
    f32x2 e; e.x = __builtin_amdgcn_exp2f(s.x); e.y = __builtin_amdgcn_exp2f(s.y);
    const f32x2 m = v * (q * e), r = v - m;
    f32x2 o; o.x = v.x < 0.f ? m.x : r.x; o.y = v.y < 0.f ? m.y : r.y; return o;
}

template <int ACT  > struct EpiBf16 {
    static constexpr bool PERM = true, AFTER_DRAIN = false; static_assert(ACT == 0 || ACT == 1, "EpiBf16: ACT is 0 (none) or 1 (gelu_pk)");
    bf16_t* O; int ldc; const float* bias; int split_cols; size_t split_stride; float scale0;
    __device__ __forceinline__ void operator()(const f32x4 (&acc)[2][2][4][2], const Unit& u, int wr, int wc, int fr, int fq) const {
        const int row0 = u.pm * BM + wr * 64 + fr; int colt = u.pn * BM; bf16_t* base = O;
        float sc = 1.f; if (split_cols) { const int t = colt / split_cols; base += (size_t)t * split_stride; colt -= t * split_cols; if (t == 0) sc = scale0; }
        const int col0 = colt + wc * 32 + 8 * fq, bcol0 = u.pn * BM + wc * 32 + 8 * fq;
        f32x4 bv[2][2];
#pragma unroll
        for (int bj = 0; bj < 2; ++bj)
#pragma unroll
            for (int n = 0; n < 2; ++n) bv[bj][n] = bias ? *(const f32x4*)(bias + bcol0 + bj * HALF + 4 * n) : (f32x4){0.f, 0.f, 0.f, 0.f};
#pragma unroll
        for (int ai = 0; ai < 2; ++ai)
#pragma unroll
            for (int m = 0; m < 4; ++m) { bf16_t* rowp = base + (size_t)(row0 + ai * HALF + m * 16) * ldc + col0;
#pragma unroll
                for (int bj = 0; bj < 2; ++bj) { f32x4 v0 = acc[ai][bj][m][0] + bv[bj][0], v1 = acc[ai][bj][m][1] + bv[bj][1];
                    if (ACT == 1) { f32x2 a = gelu_pk((f32x2){v0[0], v0[1]}), b = gelu_pk((f32x2){v0[2], v0[3]}), c = gelu_pk((f32x2){v1[0], v1[1]}), d = gelu_pk((f32x2){v1[2], v1[3]});
                        v0 = (f32x4){a.x, a.y, b.x, b.y}; v1 = (f32x4){c.x, c.y, d.x, d.y}; }
                    v0 = v0 * sc; v1 = v1 * sc; u32x4 w; w.x = cvt_pk_bf16(v0[0], v0[1]); w.y = cvt_pk_bf16(v0[2], v0[3]); w.z = cvt_pk_bf16(v1[0], v1[1]); w.w = cvt_pk_bf16(v1[2], v1[3]);
                    *(u32x4*)(rowp + bj * HALF) = w; } }
    }
};

template <class Epi, class Sched, bool ALIGN_EPI = false, bool SP2 = false>
__device__ __forceinline__ void gemm_phase(PG8_LAS unsigned char* lds, const Gemm g, const Sched& S, const Epi& E) {
    const int tid = threadIdx.x, wid = __builtin_amdgcn_readfirstlane(tid >> 6), lane = tid & 63, wr = wid >> 2, wc = wid & 3, fr = lane & 15, fq = lane >> 4;
    const int K = g.K, nt = K / BK;
    unsigned voffA[2], voffB[2];
#pragma unroll
    for (int i = 0; i < 2; ++i) { int R, C; stage_rc(tid * 16 + i * 8192, R, C); const int Rb = Epi::PERM ? ((R & ~31) + perm32(R & 31)) : R;
        voffA[i] = (unsigned)(R * K + C) * 2u; voffB[i] = (unsigned)(Rb * K + C) * 2u; }
    const size_t kstep = (size_t)(BK * 2);
    const size_t hstep = (size_t)HALF * K * 2;
    const size_t tstep = 2 * hstep; const size_t astep = (size_t)g.arows * K * 2;
    const unsigned ldsw = (unsigned)wid * 1024u;
    const int aoff = lds_byte(wr * 64 + fr, fq * 8), boff = lds_byte(wc * 32 + fr, fq * 8);
#define PG8_SA(b, h) (((b) * 2 + (h)) * HTB)
#define PG8_SB(b, h) ((4 + (b) * 2 + (h)) * HTB)
#define PG8_STAGE(bufoff, gbase, voff) do { _Pragma("unroll") for (int _i = 0; _i < 2; ++_i) \
        __builtin_amdgcn_global_load_lds((const unsigned*)((const char*)(gbase) + (voff)[_i]), (PG8_LAS unsigned*)(lds + (bufoff) + ldsw + _i * 8192), 16, 0, 0); } while (0)
#define PG8_LDA(dst, b, h) do { _Pragma("unroll") for (int m = 0; m < 4; ++m) _Pragma("unroll") for (int k = 0; k < 2; ++k) dst[m][k] = *(const PG8_LAS bf16x8*)(lds + PG8_SA(b, h) + aoff + m * 2048 + k * 1024); } while (0)
#define PG8_LDB(dst, b, h) do { _Pragma("unroll") for (int n = 0; n < 2; ++n) _Pragma("unroll") for (int k = 0; k < 2; ++k) dst[n][k] = *(const PG8_LAS bf16x8*)(lds + PG8_SB(b, h) + boff + n * 2048 + k * 1024); } while (0)
#define PG8_MMA(ai, bj, At, Bt) do { __builtin_amdgcn_s_setprio(1); _Pragma("unroll") for (int m = 0; m < 4; ++m) _Pragma("unroll") for (int n = 0; n < 2; ++n) _Pragma("unroll") for (int k = 0; k < 2; ++k) \
        acc[ai][bj][m][n] = __builtin_amdgcn_mfma_f32_16x16x32_bf16(Bt[n][k], At[m][k], acc[ai][bj][m][n], 0, 0, 0); __builtin_amdgcn_s_setprio(0); } while (0)
#define PG8_WAIT_V(n) asm volatile("s_waitcnt vmcnt(" #n ")" ::: "memory")
#define PG8_WAIT_L(n) asm volatile("s_waitcnt lgkmcnt(" #n ")" ::: "memory")
#define PG8_BAR __builtin_amdgcn_s_barrier()
#define PG8_SCHED __builtin_amdgcn_sched_barrier(0)
    Unit cur, nxt; int ui = 0;
    if (!S.next(0, cur)) return;
    f32x4 acc[2][2][4][2];
#pragma unroll
    for (int a = 0; a < 2; ++a)
#pragma unroll
        for (int b = 0; b < 2; ++b)
#pragma unroll
            for (int m = 0; m < 4; ++m)
#pragma unroll
                for (int n = 0; n < 2; ++n) acc[a][b][m][n] = (f32x4){0.f, 0.f, 0.f, 0.f};
    bf16x8 At[4][2], B0[2][2], B1[2][2];
    const char* cA = (const char*)g.A + (size_t)cur.pm * astep; const char* cB = (const char*)g.Bt + (size_t)cur.pn * tstep;
    S.a_ready(cur);
    if constexpr (SP2) {
        PG8_STAGE(PG8_SB(0, 0), cB, voffB); PG8_STAGE(PG8_SB(0, 1), cB + hstep, voffB); PG8_STAGE(PG8_SA(0, 0), cA, voffA); PG8_STAGE(PG8_SA(0, 1), cA + hstep, voffA);
        if (wr == 1) PG8_BAR;
        PG8_WAIT_V(2); PG8_BAR;
        PG8_STAGE(PG8_SB(1, 0), cB + kstep, voffB); PG8_STAGE(PG8_SA(1, 0), cA + kstep, voffA); PG8_STAGE(PG8_SB(1, 1), cB + hstep + kstep, voffB);
        PG8_WAIT_V(6); PG8_BAR;
    } else {
        PG8_STAGE(PG8_SB(0, 0), cB, voffB); PG8_STAGE(PG8_SA(0, 0), cA, voffA); PG8_STAGE(PG8_SB(0, 1), cB + hstep, voffB); PG8_STAGE(PG8_SA(0, 1), cA + hstep, voffA);
        if (wr == 1) PG8_BAR;
        PG8_WAIT_V(4); PG8_BAR;
        PG8_STAGE(PG8_SB(1, 0), cB + kstep, voffB); PG8_STAGE(PG8_SA(1, 0), cA + kstep, voffA); PG8_STAGE(PG8_SB(1, 1), cB + hstep + kstep, voffB);
        PG8_WAIT_V(6); PG8_BAR;
    }
    for (;;) {
        const bool has_next = S.next(ui + 1, nxt);
        const char* nA = has_next ? (const char*)g.A + (size_t)nxt.pm * astep : cA; const char* nB = has_next ? (const char*)g.Bt + (size_t)nxt.pn * tstep : cB;
        for (int t = 0; t < nt; t += 2) {
            const bool last = (t == nt - 2);
            const char* a1 = cA + (size_t)(t + 1) * kstep;
            const char* a2 = last ? nA : cA + (size_t)(t + 2) * kstep; const char* b2 = last ? nB : cB + (size_t)(t + 2) * kstep;
            const char* a3 = a2 + kstep; const char* b3 = b2 + kstep;
            if (last && has_next) S.a_ready(nxt);
            if constexpr (SP2) {
            PG8_LDB(B0, 0, 0); PG8_LDB(B1, 0, 1); PG8_SCHED; PG8_LDA(At, 0, 0); PG8_STAGE(PG8_SA(1, 1), a1 + hstep, voffA);
            PG8_WAIT_V(8); PG8_WAIT_L(0); PG8_BAR; PG8_MMA(0, 0, At, B0); PG8_MMA(0, 1, At, B1); PG8_BAR; PG8_SCHED;
            PG8_LDA(At, 0, 1); PG8_STAGE(PG8_SB(0, 0), b2, voffB); PG8_STAGE(PG8_SB(0, 1), b2 + hstep, voffB); PG8_STAGE(PG8_SA(0, 0), a2, voffA);
            PG8_WAIT_V(8); PG8_WAIT_L(0); PG8_BAR; PG8_MMA(1, 0, At, B0); PG8_MMA(1, 1, At, B1); PG8_BAR; PG8_SCHED;
            PG8_LDB(B0, 1, 0); PG8_LDB(B1, 1, 1); PG8_SCHED; PG8_LDA(At, 1, 0); PG8_STAGE(PG8_SA(0, 1), a2 + hstep, voffA);
            PG8_WAIT_V(8); PG8_WAIT_L(0); PG8_BAR; PG8_MMA(0, 0, At, B0); PG8_MMA(0, 1, At, B1); PG8_BAR; PG8_SCHED;
            PG8_LDA(At, 1, 1); PG8_STAGE(PG8_SB(1, 0), b3, voffB); PG8_STAGE(PG8_SB(1, 1), b3 + hstep, voffB); PG8_STAGE(PG8_SA(1, 0), a3, voffA);
            PG8_WAIT_V(8); PG8_WAIT_L(0); PG8_BAR; PG8_MMA(1, 0, At, B0); PG8_MMA(1, 1, At, B1); PG8_BAR; PG8_SCHED;
            } else {
            PG8_LDB(B0, 0, 0); PG8_SCHED; PG8_LDA(At, 0, 0); PG8_STAGE(PG8_SA(1, 1), a1 + hstep, voffA);
            PG8_WAIT_L(8); PG8_BAR; PG8_WAIT_L(0); PG8_MMA(0, 0, At, B0); PG8_BAR; PG8_SCHED;
            PG8_LDB(B1, 0, 1); PG8_STAGE(PG8_SB(0, 0), b2, voffB);
            PG8_BAR; PG8_WAIT_L(0); PG8_MMA(0, 1, At, B1); PG8_BAR;
            PG8_LDA(At, 0, 1); PG8_STAGE(PG8_SA(0, 0), a2, voffA);
            PG8_BAR; PG8_WAIT_L(0); PG8_MMA(1, 0, At, B0); PG8_BAR; PG8_SCHED;
            PG8_STAGE(PG8_SB(0, 1), b2 + hstep, voffB);
            PG8_WAIT_V(6); PG8_BAR; PG8_MMA(1, 1, At, B1); PG8_BAR;
            PG8_LDB(B0, 1, 0); PG8_SCHED; PG8_LDA(At, 1, 0); PG8_STAGE(PG8_SA(0, 1), a2 + hstep, voffA);
            PG8_WAIT_L(8); PG8_BAR; PG8_WAIT_L(0); PG8_MMA(0, 0, At, B0); PG8_BAR; PG8_SCHED;
            PG8_LDB(B1, 1, 1); PG8_STAGE(PG8_SB(1, 0), b3, voffB);
            PG8_BAR; PG8_WAIT_L(0); PG8_MMA(0, 1, At, B1); PG8_BAR;
            PG8_LDA(At, 1, 1); PG8_STAGE(PG8_SA(1, 0), a3, voffA);
            PG8_BAR; PG8_WAIT_L(0); PG8_MMA(1, 0, At, B0); PG8_BAR; PG8_SCHED;
            PG8_STAGE(PG8_SB(1, 1), b3 + hstep, voffB);
            PG8_WAIT_V(6); PG8_BAR; PG8_MMA(1, 1, At, B1); PG8_BAR;
            }
        }
        if constexpr (ALIGN_EPI) { if (wr == 0) PG8_BAR; }
        if constexpr (!Epi::AFTER_DRAIN) { E(acc, cur, wr, wc, fr, fq); S.done(cur); }
        if (!has_next) break;
#pragma unroll
        for (int a = 0; a < 2; ++a)
#pragma unroll
            for (int b = 0; b < 2; ++b)
#pragma unroll
                for (int m = 0; m < 4; ++m)
#pragma unroll
                    for (int n = 0; n < 2; ++n) acc[a][b][m][n] = (f32x4){0.f, 0.f, 0.f, 0.f};
        cur = nxt; cA = nA; cB = nB; ++ui;
        if constexpr (ALIGN_EPI) { if (wr == 1) PG8_BAR; }
    }
    PG8_WAIT_V(0);
    if constexpr (!ALIGN_EPI) { if (wr == 0) PG8_BAR; }
    PG8_BAR;
    if constexpr (Epi::AFTER_DRAIN) { E.fused(acc, cur, wr, wc, fr, fq, lds, wid, lane); S.done(cur); }
#undef PG8_SA
#undef PG8_SB
#undef PG8_STAGE
#undef PG8_LDA
#undef PG8_LDB
#undef PG8_MMA
#undef PG8_WAIT_V
#undef PG8_WAIT_L
#undef PG8_BAR
#undef PG8_SCHED
}
}

#ifndef MK_PER_PHASE
#define MK_PER_PHASE 0
#endif
#define LAS __attribute__((address_space(3)))
typedef unsigned short bf16;
typedef float f32x4 __attribute__((ext_vector_type(4)));
typedef float f32x2 __attribute__((ext_vector_type(2)));
typedef float f32x16 __attribute__((ext_vector_type(16)));
typedef unsigned u32x4 __attribute__((ext_vector_type(4)));
typedef unsigned u32x2 __attribute__((ext_vector_type(2)));
typedef short bf16x8 __attribute__((ext_vector_type(8)));

constexpr int M = 16384, D = 1024, NPROJ = 3584, INC = 3592, DFF = 2816, NUP = 5632, NMOD = 6144;
constexpr float ALPHA_F = 1.18920711500272f;
constexpr float LN_EPS = 1e-5f, GN_EPS = 1e-6f;
constexpr float LOG2E = 1.4426950408889634f;
constexpr float C2 = 0.125f * LOG2E;
constexpr int NPH = 11;
constexpr int NSL = 32;

constexpr size_t MiB = 1u << 20;
constexpr size_t WS_CTL = 0, CTL_BYTES = 4096;
constexpr size_t WS_MODF = 64 * 1024;
constexpr size_t WS_PART = 1 * MiB;
constexpr size_t WS_WIN = 2 * MiB, WS_WO = 9 * MiB, WS_WUP = 11 * MiB, WS_WDN = 22 * MiB;
constexpr size_t WS_CS = 28 * MiB;
constexpr size_t WS_LOGF = 36 * MiB;
constexpr size_t WS_CB = 37 * MiB;
constexpr size_t WS_H = 38 * MiB;
constexpr size_t WS_RT = 38 * MiB;
constexpr size_t WS_FQ = 71 * MiB;
constexpr size_t WS_ATT = 183 * MiB;
constexpr size_t WS_KV = 215 * MiB;
constexpr size_t WS_ACT = 71 * MiB;
constexpr size_t WS_END = 256 * MiB;
constexpr int LDS_BYTES = 147456;
constexpr int XCH_OFF = 131072;

#define LDS_WAIT() asm volatile("s_waitcnt lgkmcnt(0)" ::: "memory")
__device__ __forceinline__ unsigned f2bf(float f) { unsigned u = __builtin_bit_cast(unsigned, f); return (u + 0x7fffu + ((u >> 16) & 1u)) >> 16; }
__device__ __forceinline__ unsigned pk2(float lo, float hi) { return f2bf(lo) | (f2bf(hi) << 16); }
__device__ __forceinline__ float bflo(unsigned w) { return __builtin_bit_cast(float, w << 16); }
__device__ __forceinline__ float bfhi(unsigned w) { return __builtin_bit_cast(float, w & 0xffff0000u); }
__device__ __forceinline__ int crow(int r, int hi) { return (r & 3) + 8 * (r >> 2) + 4 * hi; }
__device__ __forceinline__ float wave_sum(float v) {
#pragma unroll
    for (int o = 1; o < 64; o <<= 1) v += __shfl_xor(v, o);
    return v;
}
__device__ __forceinline__ int kvpos(int m0) { return 16 * (m0 >> 4) + 8 * ((m0 >> 2) & 1) + 4 * ((m0 >> 3) & 1); }
template <int CTRL> __device__ __forceinline__ float dppz(float v) { return __builtin_bit_cast(float, __builtin_amdgcn_update_dpp(0, __builtin_bit_cast(int, v), CTRL, 0xF, 0xF, true)); }

struct EpiRes {
    static constexpr bool PERM = false, AFTER_DRAIN = false;
    const float* X; float* out; const float* gate; float alpha;
    __device__ __forceinline__ void operator()(const pg8::f32x4 (&acc)[2][2][4][2], const pg8::Unit& u, int wr, int wc, int fr, int fq) const {
        const int col0 = u.pn * 256 + wc * 32 + 4 * fq;
        f32x4 gv[2][2];
#pragma unroll
        for (int bj = 0; bj < 2; ++bj)
#pragma unroll
            for (int n = 0; n < 2; ++n) gv[bj][n] = *(const f32x4*)(gate + col0 + bj * 128 + n * 16);
#pragma unroll
        for (int ai = 0; ai < 2; ++ai)
#pragma unroll
            for (int m = 0; m < 4; ++m) { const size_t off = (size_t)(u.pm * 256 + ai * 128 + wr * 64 + m * 16 + fr) * D + col0;
#pragma unroll
                for (int bj = 0; bj < 2; ++bj)
#pragma unroll
                    for (int n = 0; n < 2; ++n) { const f32x4 xv = *(const f32x4*)(X + off + bj * 128 + n * 16);
                        const f32x4 o = xv * alpha + gv[bj][n] * acc[ai][bj][m][n]; *(f32x4*)(out + off + bj * 128 + n * 16) = o; }
                if (m & 1) asm volatile("" ::: "memory"); }
    }
};
struct EpiGeglu {
    static constexpr bool PERM = true, AFTER_DRAIN = false;
    bf16* act; const float* cw; const float* cbias; LAS unsigned char* xch;
    __device__ __forceinline__ void operator()(const pg8::f32x4 (&acc)[2][2][4][2], const pg8::Unit& u, int wr, int wc, int fr, int fq) const {
        if (fr >= 14) {
#pragma unroll
            for (int ai = 0; ai < 2; ++ai)
#pragma unroll
                for (int bj = 0; bj < 2; ++bj)
#pragma unroll
                    for (int n = 0; n < 2; ++n)
                        *(LAS f32x4*)(xch + ((((ai * 2 + wr) * 2 + (fr - 14)) * 256) + bj * 128 + wc * 32 + 8 * fq + 4 * n) * 4) = acc[ai][bj][3][n];
        }
        asm volatile("s_waitcnt lgkmcnt(0)" ::: "memory"); __builtin_amdgcn_s_barrier(); asm volatile("" ::: "memory");
        const int ca0 = u.pn * 128 + wc * 32 + 8 * fq;
        u32x2 keep[2][4];
#pragma unroll
        for (int n = 0; n < 2; ++n) {
            const int ca = ca0 + 4 * n;
            const f32x4 wa0 = *(const f32x4*)(cw + ca), wa1 = *(const f32x4*)(cw + NUP + ca), wa2 = *(const f32x4*)(cw + 2 * NUP + ca), ba = *(const f32x4*)(cbias + ca);
            const f32x4 wb0 = *(const f32x4*)(cw + DFF + ca), wb1 = *(const f32x4*)(cw + NUP + DFF + ca), wb2 = *(const f32x4*)(cw + 2 * NUP + DFF + ca), bb = *(const f32x4*)(cbias + DFF + ca);
#pragma unroll
            for (int ai = 0; ai < 2; ++ai) {
                f32x4 pa = (f32x4){0.f, 0.f, 0.f, 0.f}, pb = pa;
                const int pai = wr ? ai : ai - 1, pwr = wr ? 0 : 1;
                if (pai >= 0 && fr >= 14) {
                    pa = *(const LAS f32x4*)(xch + ((((pai * 2 + pwr) * 2 + (fr - 14)) * 256) + 0 * 128 + wc * 32 + 8 * fq + 4 * n) * 4);
                    pb = *(const LAS f32x4*)(xch + ((((pai * 2 + pwr) * 2 + (fr - 14)) * 256) + 1 * 128 + wc * 32 + 8 * fq + 4 * n) * 4);
                }
#pragma unroll
                for (int m = 0; m < 4; ++m) {
                    const f32x4 ca_ = acc[ai][0][m][n], cb_ = acc[ai][1][m][n];
                    const f32x4 qa = m ? acc[ai][0][m - 1][n] : pa, qb = m ? acc[ai][1][m - 1][n] : pb;
                    float ya[4], yb[4];
#pragma unroll
                    for (int i = 0; i < 4; ++i) {
                        const float a1 = dppz<0x111>(ca_[i]) + dppz<0x10F>(qa[i]);
                        const float a2 = dppz<0x112>(ca_[i]) + dppz<0x10E>(qa[i]);
                        const float b1 = dppz<0x111>(cb_[i]) + dppz<0x10F>(qb[i]);
                        const float b2 = dppz<0x112>(cb_[i]) + dppz<0x10E>(qb[i]);
                        ya[i] = ba[i] + wa2[i] * ca_[i] + wa1[i] * a1 + wa0[i] * a2;
                        yb[i] = bb[i] + wb2[i] * cb_[i] + wb1[i] * b1 + wb0[i] * b2;
                    }
                    const pg8::f32x2 g0 = pg8::gelu_pk((pg8::f32x2){ya[0], ya[1]}), g1 = pg8::gelu_pk((pg8::f32x2){ya[2], ya[3]});
                    u32x2 w; w.x = pg8::cvt_pk_bf16(g0.x * yb[0], g0.y * yb[1]); w.y = pg8::cvt_pk_bf16(g1.x * yb[2], g1.y * yb[3]);
                    if (n == 0) keep[ai][m] = w;
                    else {
                        const int row = ai * 128 + wr * 64 + m * 16 + fr, t = u.pm * 254 - 2 + row;
                        if (row >= 2 && t < M) { u32x4 o; o.x = keep[ai][m].x; o.y = keep[ai][m].y; o.z = w.x; o.w = w.y; *(u32x4*)(act + (size_t)t * DFF + ca0) = o; }
                    }
                }
            }
        }
    }
};

struct Args { const float* in[15]; float* out; unsigned char* ws; int ph_lo, ph_hi; };

struct Ctx {
    LAS unsigned char* L; int tid, lane, wave, G, vcu;
};

__device__ __forceinline__ void tr_item(const float* W, int ldw, int src_col0, int k0, bf16* WT, int K, int dst_row0, LAS float* scr, int lane) {
#pragma unroll 8
    for (int i = 0; i < 32; ++i) { const int kk = 2 * i + (lane >> 5); scr[kk * 33 + (lane & 31)] = W[(size_t)(k0 + kk) * ldw + src_col0 + (lane & 31)]; }
    LDS_WAIT(); asm volatile("" ::: "memory");
    const int c = lane & 7;
#pragma unroll
    for (int j = 0; j < 4; ++j) { const int n = (lane >> 3) + 8 * j; const LAS float* s = scr + (8 * c) * 33 + n;
        u32x4 o; o.x = pk2(s[0 * 33], s[1 * 33]); o.y = pk2(s[2 * 33], s[3 * 33]); o.z = pk2(s[4 * 33], s[5 * 33]); o.w = pk2(s[6 * 33], s[7 * 33]);
        *(u32x4*)(WT + (size_t)(dst_row0 + n) * K + k0 + 8 * c) = o; }
    LDS_WAIT(); asm volatile("" ::: "memory");
}

__device__ __forceinline__ void phase_p0a(const Ctx& C, const Args& a) {
    unsigned char* ws = a.ws;
    const float* cvec = a.in[1]; const float* w_ada = a.in[2];
    if ((int)blockIdx.x < NSL * 3) {
        const int s = blockIdx.x / 3, cgp = blockIdx.x % 3, col4 = cgp * 512 + C.tid;
        f32x4 acc = (f32x4){0.f, 0.f, 0.f, 0.f};
        for (int i = 32 * s; i < 32 * s + 32; ++i) { const float cv = cvec[i]; const float sv = cv / (1.f + __expf(-cv));
            const f32x4 w = *(const f32x4*)(w_ada + (size_t)i * NMOD + 4 * col4); acc += w * sv; }
        *(f32x4*)((float*)(ws + WS_PART) + (size_t)s * NMOD + 4 * col4) = acc;
    }
    { f32x2* CS = (f32x2*)(ws + WS_CS); const int gt = C.vcu * 512 + C.tid, NT = C.G * 512;
      for (int idx = gt; idx < M * 64; idx += NT) { const int t = idx >> 6, i = idx & 63;
          const float inv = powf(10000.f, -(float)i / 64.f); const float ang = (float)t * inv;
          const double ad = (double)ang; const double rev = ad * 0.15915494309189535; const double fr = rev - rint(rev);
          const float rad = (float)(fr * 6.283185307179586);
          CS[idx] = (f32x2){__cosf(rad), __sinf(rad)}; } }
    LAS float* scr = (LAS float*)(C.L + C.wave * 16384);
    const int gw = C.vcu * 8 + C.wave, NGW = C.G * 8;
    constexpr int I_IN = 16 * 112, I_O = 16 * 32, I_UP = 16 * 176, I_DN = 44 * 32, NIT = I_IN + I_O + I_UP + I_DN;
    bf16* Win = (bf16*)(ws + WS_WIN); bf16* Wo = (bf16*)(ws + WS_WO); bf16* Wup = (bf16*)(ws + WS_WUP); bf16* Wdn = (bf16*)(ws + WS_WDN);
    for (int it = gw; it < NIT; it += NGW) {
        int r = it;
        if (r < I_IN) { const int kb = r / 112, nb = r % 112, n0 = 32 * nb; tr_item(a.in[4], INC, n0 < 1536 ? n0 : n0 + 8, 64 * kb, Win, D, n0, scr, C.lane); continue; } r -= I_IN;
        if (r < I_O) { const int kb = r / 32, nb = r % 32; tr_item(a.in[6], D, 32 * nb, 64 * kb, Wo, D, 32 * nb, scr, C.lane); continue; } r -= I_O;
        if (r < I_UP) { const int kb = r / 176, nb = r % 176, n0 = 32 * nb, pn = n0 >> 8, rr = n0 & 255; const int src = rr < 128 ? 128 * pn + rr : DFF + 128 * pn + (rr - 128);
            tr_item(a.in[9], NUP, src, 64 * kb, Wup, D, n0, scr, C.lane); continue; } r -= I_UP;
        { const int kb = r / 32, nb = r % 32; tr_item(a.in[12], D, 32 * nb, 64 * kb, Wdn, DFF, 32 * nb, scr, C.lane); }
    }
}

__device__ __forceinline__ void phase_p0b(const Ctx& C, const Args& a) {
    unsigned char* ws = a.ws;
    const float* part = (const float*)(ws + WS_PART); const float* b_ada = a.in[3];
    LAS float* modl = (LAS float*)C.L;
    LAS float* wff = (LAS float*)(C.L + 8192);
    const int nv = (blockIdx.x == 0) ? NMOD : 2048;
    for (int v = C.tid; v < nv; v += 512) { float s = b_ada[v];
        for (int k = 0; k < NSL; ++k) s += part[(size_t)k * NMOD + v];
        if (v < 2048) modl[v] = s;
        if (blockIdx.x == 0) ((float*)(ws + WS_MODF))[v] = s; }
    const float* w_in = a.in[4];
    for (int e = C.tid; e < 8192; e += 512) wff[e] = w_in[(size_t)(e >> 3) * INC + 1536 + (e & 7)];
    __syncthreads();
    const float* x = a.in[0]; const float* b_f = a.in[5];
    bf16* H = (bf16*)(ws + WS_H) + 2 * D; float* LOGF = (float*)(ws + WS_LOGF);
    const int gw = C.vcu * 8 + C.wave, NGW = C.G * 8;
    for (int t = gw; t < M; t += NGW) {
        const f32x4* xr = (const f32x4*)(x + (size_t)t * D) + C.lane;
        float pf[8];
#pragma unroll
        for (int f = 0; f < 8; ++f) pf[f] = 0.f;
        unsigned long long* o8 = (unsigned long long*)(H + (size_t)t * D) + C.lane;
#pragma unroll
        for (int j = 0; j < 4; ++j) {
            const f32x4 xv = xr[64 * j]; const int c0 = 256 * j + 4 * C.lane;
            const f32x4 sh = *(const LAS f32x4*)(modl + c0), sc = *(const LAS f32x4*)(modl + 1024 + c0);
            const f32x4 hv = xv * (sc + 1.0f) + sh;
            o8[64 * j] = (unsigned long long)pk2(hv.x, hv.y) | ((unsigned long long)pk2(hv.z, hv.w) << 32);
#pragma unroll
            for (int e = 0; e < 4; ++e) { const f32x4 w0 = *(const LAS f32x4*)(wff + (c0 + e) * 8), w1 = *(const LAS f32x4*)(wff + (c0 + e) * 8 + 4);
                const float hh = hv[e];
                pf[0] += hh * w0.x; pf[1] += hh * w0.y; pf[2] += hh * w0.z; pf[3] += hh * w0.w; pf[4] += hh * w1.x; pf[5] += hh * w1.y; pf[6] += hh * w1.z; pf[7] += hh * w1.w; }
        }
#pragma unroll
        for (int f = 0; f < 8; ++f) pf[f] = wave_sum(pf[f]);
        float z = pf[0];
#pragma unroll
        for (int f = 1; f < 8; ++f) z = (C.lane == f) ? pf[f] : z;
        if (C.lane < 8) { z += b_f[C.lane]; const float lf = fminf(z, 0.f) - log1pf(__expf(-fabsf(z))); LOGF[(size_t)C.lane * M + t] = lf; }
    }
}

__device__ __forceinline__ float lg2gamma(int h) { return log2f(1.0f - exp2f(-5.0f - (float)h)); }

__device__ __forceinline__ void ret_kv_unit(const Ctx& C, const Args& a, int h, int ck) {
    unsigned char* ws = a.ws;
    const bf16* RK = (const bf16*)(ws + WS_FQ + 4 * 16 * MiB); const bf16* RV = (const bf16*)(ws + WS_FQ + 5 * 16 * MiB);
    const f32x2* CS = (const f32x2*)(ws + WS_CS); float* KV = (float*)(ws + WS_KV);
    LAS unsigned char* Kt = C.L; LAS unsigned char* Vt = C.L + 34816;
    const int t0 = 128 * ck; const float lg = lg2gamma(h);
    __syncthreads();
    if (C.tid < 256) {
        const int tg = C.tid >> 3, dc = C.tid & 7;
        unsigned lo[4][4], hi_[4][4];
#pragma unroll
        for (int tt = 0; tt < 4; ++tt) { const int m = 4 * tg + tt, t = t0 + m;
            const u32x4 klo = *(const u32x4*)(RK + (size_t)t * 512 + 128 * h + 8 * dc), khi = *(const u32x4*)(RK + (size_t)t * 512 + 128 * h + 64 + 8 * dc);
            const float sc = 0.08838834764831845f * exp2f((float)(127 - m) * lg);
            const f32x4* cs4 = (const f32x4*)(CS + (size_t)t * 64 + 8 * dc);
#pragma unroll
            for (int e2 = 0; e2 < 4; ++e2) { const f32x4 cs = cs4[e2];
                const float l0 = bflo(klo[e2]), l1 = bfhi(klo[e2]), h0 = bflo(khi[e2]), h1 = bfhi(khi[e2]);
                lo[tt][e2] = pk2((l0 * cs.x - h0 * cs.y) * sc, (l1 * cs.z - h1 * cs.w) * sc);
                hi_[tt][e2] = pk2((h0 * cs.x + l0 * cs.y) * sc, (h1 * cs.z + l1 * cs.w) * sc); } }
#pragma unroll
        for (int e2 = 0; e2 < 4; ++e2) {
            u32x2 w;
            w.x = (lo[0][e2] & 0xffffu) | (lo[1][e2] << 16); w.y = (lo[2][e2] & 0xffffu) | (lo[3][e2] << 16); *(LAS u32x2*)(Kt + (8 * dc + 2 * e2) * 272 + tg * 8) = w;
            w.x = (lo[0][e2] >> 16) | (lo[1][e2] & 0xffff0000u); w.y = (lo[2][e2] >> 16) | (lo[3][e2] & 0xffff0000u); *(LAS u32x2*)(Kt + (8 * dc + 2 * e2 + 1) * 272 + tg * 8) = w;
            w.x = (hi_[0][e2] & 0xffffu) | (hi_[1][e2] << 16); w.y = (hi_[2][e2] & 0xffffu) | (hi_[3][e2] << 16); *(LAS u32x2*)(Kt + (64 + 8 * dc + 2 * e2) * 272 + tg * 8) = w;
            w.x = (hi_[0][e2] >> 16) | (hi_[1][e2] & 0xffff0000u); w.y = (hi_[2][e2] >> 16) | (hi_[3][e2] & 0xffff0000u); *(LAS u32x2*)(Kt + (64 + 8 * dc + 2 * e2 + 1) * 272 + tg * 8) = w;
        }
    } else {
        const int vt = C.tid - 256;
#pragma unroll
        for (int it = 0; it < 2; ++it) { const int item = vt + 256 * it, tg = item >> 4, dc = item & 15;
            u32x4 v[4];
#pragma unroll
            for (int tt = 0; tt < 4; ++tt) v[tt] = *(const u32x4*)(RV + (size_t)(t0 + 4 * tg + tt) * 512 + 128 * h + 8 * dc);
#pragma unroll
            for (int e2 = 0; e2 < 4; ++e2) { u32x2 w;
                w.x = (v[0][e2] & 0xffffu) | (v[1][e2] << 16); w.y = (v[2][e2] & 0xffffu) | (v[3][e2] << 16); *(LAS u32x2*)(Vt + (8 * dc + 2 * e2) * 272 + tg * 8) = w;
                w.x = (v[0][e2] >> 16) | (v[1][e2] & 0xffff0000u); w.y = (v[2][e2] >> 16) | (v[3][e2] & 0xffff0000u); *(LAS u32x2*)(Vt + (8 * dc + 2 * e2 + 1) * 272 + tg * 8) = w; } }
    }
    __syncthreads();
    const int r32 = C.lane & 31, hi = C.lane >> 5, dvb = C.wave >> 1, dkh = C.wave & 1;
    f32x16 acc0 = {}, acc1 = {};
#pragma unroll
    for (int ks = 0; ks < 8; ++ks) {
        const bf16x8 A = *(const LAS bf16x8*)(Vt + (32 * dvb + r32) * 272 + (16 * ks + 8 * hi) * 2);
        const bf16x8 B0 = *(const LAS bf16x8*)(Kt + (64 * dkh + r32) * 272 + (16 * ks + 8 * hi) * 2);
        const bf16x8 B1 = *(const LAS bf16x8*)(Kt + (64 * dkh + 32 + r32) * 272 + (16 * ks + 8 * hi) * 2);
        acc0 = __builtin_amdgcn_mfma_f32_32x32x16_bf16(A, B0, acc0, 0, 0, 0);
        acc1 = __builtin_amdgcn_mfma_f32_32x32x16_bf16(A, B1, acc1, 0, 0, 0);
    }
    float* dst = KV + ((size_t)(h * 128 + ck) * 128 + 32 * dvb) * 128 + 64 * dkh + r32;
#pragma unroll
    for (int r = 0; r < 16; ++r) { dst[(size_t)crow(r, hi) * 128] = acc0[r]; dst[(size_t)crow(r, hi) * 128 + 32] = acc1[r]; }
}

__device__ __forceinline__ void phase_p2a(const Ctx& C, const Args& a) {
    unsigned char* ws = a.ws;
    for (int u = blockIdx.x; u < 512; u += C.G) ret_kv_unit(C, a, u & 3, u >> 2);
    { const bf16* FQ = (const bf16*)(ws + WS_FQ); const bf16* FK = (const bf16*)(ws + WS_FQ + 16 * MiB); unsigned* ctl = (unsigned*)(ws + WS_CTL);
      const int gw = C.vcu * 8 + C.wave, NGW = C.G * 8; float mq = 0.f, mk = 0.f;
      for (int t = gw; t < M; t += NGW) {
          const u32x4 q = *(const u32x4*)(FQ + (size_t)t * 512 + 8 * C.lane), k = *(const u32x4*)(FK + (size_t)t * 512 + 8 * C.lane);
          float sq = 0.f, sk = 0.f;
#pragma unroll
          for (int e = 0; e < 4; ++e) { const float a0 = bflo(q[e]), a1 = bfhi(q[e]), b0 = bflo(k[e]), b1 = bfhi(k[e]); sq += a0 * a0 + a1 * a1; sk += b0 * b0 + b1 * b1; }
          sq += __shfl_xor(sq, 1); sq += __shfl_xor(sq, 2); sq += __shfl_xor(sq, 4);
          sk += __shfl_xor(sk, 1); sk += __shfl_xor(sk, 2); sk += __shfl_xor(sk, 4);
          mq = fmaxf(mq, sq); mk = fmaxf(mk, sk); }
      if ((C.lane & 7) == 0) { atomicMax(ctl + 32 + (C.lane >> 3), __float_as_uint(mq)); atomicMax(ctl + 48 + (C.lane >> 3), __float_as_uint(mk)); } }
    if ((int)blockIdx.x == C.G - 1) {
        const float* lf = (const float*)(ws + WS_LOGF) + (size_t)C.wave * M + 256 * C.lane; double* cb = (double*)(ws + WS_CB) + (size_t)C.wave * M + 256 * C.lane;
        double s = 0.0;
        for (int i = 0; i < 64; ++i) { const f32x4 v = ((const f32x4*)lf)[i]; s += ((double)v.x + (double)v.y) + ((double)v.z + (double)v.w); }
        double inc = s;
#pragma unroll
        for (int o = 1; o < 64; o <<= 1) { const double nb = __shfl_up(inc, o); if (C.lane >= o) inc += nb; }
        double run = inc - s;
        for (int i = 0; i < 64; ++i) { const f32x4 v = ((const f32x4*)lf)[i];
            run += (double)v.x; cb[4 * i] = -run * 1.4426950408889634; run += (double)v.y; cb[4 * i + 1] = -run * 1.4426950408889634;
            run += (double)v.z; cb[4 * i + 2] = -run * 1.4426950408889634; run += (double)v.w; cb[4 * i + 3] = -run * 1.4426950408889634; }
    }
}

__device__ __forceinline__ void phase_p2b(const Ctx& C, const Args& a) {
    unsigned char* ws = a.ws; const float* KV = (const float*)(ws + WS_KV); bf16* RT = (bf16*)(ws + WS_RT);
    const int gt = C.vcu * 512 + C.tid;
    if (gt < 32768) {
        const int e = 2 * gt, h = e >> 14, idx = e & 16383; const float g = exp2f(128.f * lg2gamma(h));
        float r0 = 0.f, r1 = 0.f;
        for (int i0 = 0; i0 < 128; i0 += 8) {
            f32x2 v[8];
#pragma unroll
            for (int j = 0; j < 8; ++j) v[j] = *(const f32x2*)(KV + ((size_t)(h * 128 + i0 + j) << 14) + idx);
#pragma unroll
            for (int j = 0; j < 8; ++j) { r0 = g * r0 + v[j].x; r1 = g * r1 + v[j].y; *(unsigned*)(RT + ((size_t)(h * 128 + i0 + j) << 14) + idx) = pk2(r0, r1); }
        }
    }
}

__device__ __forceinline__ void ret_out_unit(const Ctx& C, const Args& a, int h, int ck) {
    unsigned char* ws = a.ws;
    const bf16* RQ = (const bf16*)(ws + WS_FQ + 3 * 16 * MiB); const bf16* RK = (const bf16*)(ws + WS_FQ + 4 * 16 * MiB);
    const bf16* RV = (const bf16*)(ws + WS_FQ + 5 * 16 * MiB); const bf16* RG = (const bf16*)(ws + WS_FQ + 6 * 16 * MiB);
    const bf16* RT = (const bf16*)(ws + WS_RT); const f32x2* CS = (const f32x2*)(ws + WS_CS); bf16* ATT = (bf16*)(ws + WS_ATT);
    LAS unsigned char* Qs = C.L; LAS unsigned char* Ks = C.L + 34816; LAS unsigned char* Vt = C.L + 69632; LAS unsigned char* Rs = C.L + 104448; LAS f32x2* ST = (LAS f32x2*)(C.L + 139264);
    const int t0 = 128 * ck; const float lg = lg2gamma(h);
    __syncthreads();
#pragma unroll
    for (int it = 0; it < 2; ++it) { const int item = C.tid + 512 * it, m = item >> 3, dc = item & 7, t = t0 + m;
        const u32x4 qlo = *(const u32x4*)(RQ + (size_t)t * 512 + 128 * h + 8 * dc), qhi = *(const u32x4*)(RQ + (size_t)t * 512 + 128 * h + 64 + 8 * dc);
        const u32x4 klo = *(const u32x4*)(RK + (size_t)t * 512 + 128 * h + 8 * dc), khi = *(const u32x4*)(RK + (size_t)t * 512 + 128 * h + 64 + 8 * dc);
        const f32x4* cs4 = (const f32x4*)(CS + (size_t)t * 64 + 8 * dc);
        u32x4 oql, oqh, okl, okh; const float ksc = 0.08838834764831845f;
#pragma unroll
        for (int e2 = 0; e2 < 4; ++e2) { const f32x4 cs = cs4[e2];
            { const float l0 = bflo(qlo[e2]), l1 = bfhi(qlo[e2]), h0 = bflo(qhi[e2]), h1 = bfhi(qhi[e2]);
              oql[e2] = pk2(l0 * cs.x - h0 * cs.y, l1 * cs.z - h1 * cs.w); oqh[e2] = pk2(h0 * cs.x + l0 * cs.y, h1 * cs.z + l1 * cs.w); }
            { const float l0 = bflo(klo[e2]), l1 = bfhi(klo[e2]), h0 = bflo(khi[e2]), h1 = bfhi(khi[e2]);
              okl[e2] = pk2((l0 * cs.x - h0 * cs.y) * ksc, (l1 * cs.z - h1 * cs.w) * ksc); okh[e2] = pk2((h0 * cs.x + l0 * cs.y) * ksc, (h1 * cs.z + l1 * cs.w) * ksc); } }
        *(LAS u32x4*)(Qs + m * 272 + dc * 16) = oql; *(LAS u32x4*)(Qs + m * 272 + 128 + dc * 16) = oqh;
        *(LAS u32x4*)(Ks + m * 272 + dc * 16) = okl; *(LAS u32x4*)(Ks + m * 272 + 128 + dc * 16) = okh; }
    { const int tg = C.tid >> 4, dc = C.tid & 15; u32x4 v[4];
#pragma unroll
      for (int tt = 0; tt < 4; ++tt) v[tt] = *(const u32x4*)(RV + (size_t)(t0 + 4 * tg + tt) * 512 + 128 * h + 8 * dc);
      const int pos = kvpos(4 * tg);
#pragma unroll
      for (int e2 = 0; e2 < 4; ++e2) { u32x2 w;
          w.x = (v[0][e2] & 0xffffu) | (v[1][e2] << 16); w.y = (v[2][e2] & 0xffffu) | (v[3][e2] << 16); *(LAS u32x2*)(Vt + (8 * dc + 2 * e2) * 272 + pos * 2) = w;
          w.x = (v[0][e2] >> 16) | (v[1][e2] & 0xffff0000u); w.y = (v[2][e2] >> 16) | (v[3][e2] & 0xffff0000u); *(LAS u32x2*)(Vt + (8 * dc + 2 * e2 + 1) * 272 + pos * 2) = w; } }
#pragma unroll
    for (int it = 0; it < 4; ++it) { const int item = C.tid + 512 * it, dv = item >> 4, c16 = item & 15;
        u32x4 v = (u32x4){0u, 0u, 0u, 0u};
        if (ck > 0) v = *(const u32x4*)(RT + ((size_t)(h * 128 + ck - 1) << 14) + dv * 128 + 8 * c16);
        *(LAS u32x4*)(Rs + dv * 272 + c16 * 16) = v; }
    __syncthreads();
    const int r32 = C.lane & 31, hi = C.lane >> 5, nb = C.wave & 3, dh = C.wave >> 2;
    bf16x8 qf[8];
#pragma unroll
    for (int ks = 0; ks < 8; ++ks) qf[ks] = *(const LAS bf16x8*)(Qs + (32 * nb + r32) * 272 + (16 * ks + 8 * hi) * 2);
    f32x16 o0 = {}, o1 = {};
    const int n = 32 * nb + r32;
#pragma unroll
    for (int mb = 0; mb < 4; ++mb) {
        if (mb <= nb) {
            f32x16 p = {};
#pragma unroll
            for (int ks = 0; ks < 8; ++ks) { const bf16x8 A = *(const LAS bf16x8*)(Ks + (32 * mb + r32) * 272 + (16 * ks + 8 * hi) * 2); p = __builtin_amdgcn_mfma_f32_32x32x16_bf16(A, qf[ks], p, 0, 0, 0); }
#pragma unroll
            for (int r = 0; r < 16; ++r) { const int dl = n - (32 * mb + crow(r, hi)); p[r] = dl >= 0 ? p[r] * exp2f((float)dl * lg) : 0.f; }
#pragma unroll
            for (int half = 0; half < 2; ++half) {
                u32x4 pw; pw.x = pk2(p[8 * half + 0], p[8 * half + 1]); pw.y = pk2(p[8 * half + 2], p[8 * half + 3]); pw.z = pk2(p[8 * half + 4], p[8 * half + 5]); pw.w = pk2(p[8 * half + 6], p[8 * half + 7]);
                const bf16x8 B = __builtin_bit_cast(bf16x8, pw); const int ks2 = 2 * mb + half;
                const bf16x8 A0 = *(const LAS bf16x8*)(Vt + (64 * dh + r32) * 272 + (16 * ks2 + 8 * hi) * 2);
                const bf16x8 A1 = *(const LAS bf16x8*)(Vt + (64 * dh + 32 + r32) * 272 + (16 * ks2 + 8 * hi) * 2);
                o0 = __builtin_amdgcn_mfma_f32_32x32x16_bf16(A0, B, o0, 0, 0, 0); o1 = __builtin_amdgcn_mfma_f32_32x32x16_bf16(A1, B, o1, 0, 0, 0);
            }
        }
    }
    f32x16 c0 = {}, c1 = {};
#pragma unroll
    for (int ks = 0; ks < 8; ++ks) {
        const bf16x8 A0 = *(const LAS bf16x8*)(Rs + (64 * dh + r32) * 272 + (16 * ks + 8 * hi) * 2);
        const bf16x8 A1 = *(const LAS bf16x8*)(Rs + (64 * dh + 32 + r32) * 272 + (16 * ks + 8 * hi) * 2);
        c0 = __builtin_amdgcn_mfma_f32_32x32x16_bf16(A0, qf[ks], c0, 0, 0, 0); c1 = __builtin_amdgcn_mfma_f32_32x32x16_bf16(A1, qf[ks], c1, 0, 0, 0);
    }
    const float xi = exp2f((float)(n + 1) * lg);
    float s1 = 0.f, s2 = 0.f;
#pragma unroll
    for (int r = 0; r < 16; ++r) { o0[r] += c0[r] * xi; o1[r] += c1[r] * xi; s1 += o0[r] + o1[r]; s2 += o0[r] * o0[r] + o1[r] * o1[r]; }
    s1 += __shfl_xor(s1, 32); s2 += __shfl_xor(s2, 32);
    if (hi == 0) ST[C.wave * 32 + r32] = (f32x2){s1, s2};
    __syncthreads();
    { const f32x2 pr = ST[(C.wave ^ 4) * 32 + r32]; s1 += pr.x; s2 += pr.y; }
    const float mu = s1 * (1.f / 128.f), var = fmaxf(s2 * (1.f / 128.f) - mu * mu, 0.f), rstd = 1.0f / sqrtf(var + GN_EPS);
    const size_t trow = (size_t)(t0 + n);
#pragma unroll
    for (int db = 0; db < 2; ++db)
#pragma unroll
        for (int j = 0; j < 4; ++j) { const int dv = 64 * dh + 32 * db + 8 * j + 4 * hi;
            const u32x2 gw2 = *(const u32x2*)(RG + trow * 512 + 128 * h + dv);
            const float g0 = bflo(gw2.x), g1 = bfhi(gw2.x), g2 = bflo(gw2.y), g3 = bfhi(gw2.y);
            const f32x16& oo = db ? o1 : o0;
            const float v0 = (oo[4 * j] - mu) * rstd * (g0 / (1.f + __expf(-g0))), v1 = (oo[4 * j + 1] - mu) * rstd * (g1 / (1.f + __expf(-g1)));
            const float v2 = (oo[4 * j + 2] - mu) * rstd * (g2 / (1.f + __expf(-g2))), v3 = (oo[4 * j + 3] - mu) * rstd * (g3 / (1.f + __expf(-g3)));
            u32x2 w; w.x = pk2(v0, v1); w.y = pk2(v2, v3); *(u32x2*)(ATT + trow * 1024 + 512 + 128 * h + dv) = w; }
}

__device__ __forceinline__ void fox_unit(const Ctx& C, const Args& a, int h, int qb) {
    unsigned char* ws = a.ws;
    const bf16* FQ = (const bf16*)(ws + WS_FQ); const bf16* FK = (const bf16*)(ws + WS_FQ + 16 * MiB); const bf16* FV = (const bf16*)(ws + WS_FQ + 32 * MiB);
    const double* cb = (const double*)(ws + WS_CB) + (size_t)h * M; bf16* ATT = (bf16*)(ws + WS_ATT); const unsigned* ctl = (const unsigned*)(ws + WS_CTL);
    LAS unsigned char* Ks = C.L; LAS unsigned char* Vt = C.L + 9216; LAS float* Bs = (LAS float*)(C.L + 18432);
    const int tid = C.tid, lane = C.lane, r32 = lane & 31, hi = lane >> 5, w = C.wave, q0 = 256 * qb;
    const float G2 = sqrtf(__uint_as_float(ctl[32 + h]) * __uint_as_float(ctl[48 + h]));
    const float thr2 = -(152.0f + 2.0f * G2 * 1.001f);
    bf16x8 qr[4];
    { const bf16* qp = FQ + (size_t)(q0 + 32 * w + r32) * 512 + 64 * h + 8 * hi;
#pragma unroll
      for (int d0 = 0; d0 < 4; ++d0) qr[d0] = *(const bf16x8*)(qp + 16 * d0); }
    const double cref = cb[q0];
    int t_lo = 0;
    { int tb = 4 * qb - 1;
      while (tb >= 0) { const int t = tb - lane; bool skip = false;
          if (t >= 0) { const float D2 = (float)(cb[64 * t + 63] - cref); skip = D2 < thr2; }
          const unsigned long long bal = __ballot(skip);
          if (bal) { t_lo = tb - (__ffsll((long long)bal) - 1) + 1; break; }
          tb -= 64; } }
    t_lo = __builtin_amdgcn_readfirstlane(t_lo);
    const int jd = (q0 + 32 * w) >> 6;
    float m_run = -1e30f, l_run = 0.f; f32x16 o0 = {}, o1 = {};
    u32x4 kreg, vreg[4]; float breg = 0.f;
    const int krow = tid >> 3, kch = tid & 7, vtg = (tid >> 3) & 15;
#define FOX_ISSUE(t_) do { kreg = *(const u32x4*)(FK + (size_t)(64 * (t_) + krow) * 512 + 64 * h + 8 * kch); \
        if (tid < 128) { _Pragma("unroll") for (int tt = 0; tt < 4; ++tt) vreg[tt] = *(const u32x4*)(FV + (size_t)(64 * (t_) + 4 * vtg + tt) * 512 + 64 * h + 8 * kch); } \
        else if (tid < 192) breg = (float)(cb[64 * (t_) + tid - 128] - cref); } while (0)
    int t = 4 * qb + 3;
    FOX_ISSUE(t);
    for (;;) {
        __syncthreads();
        *(LAS u32x4*)(Ks + krow * 144 + kch * 16) = kreg;
        if (tid < 128) { const int pos = kvpos(4 * vtg);
#pragma unroll
            for (int e2 = 0; e2 < 4; ++e2) { u32x2 ww;
                ww.x = (vreg[0][e2] & 0xffffu) | (vreg[1][e2] << 16); ww.y = (vreg[2][e2] & 0xffffu) | (vreg[3][e2] << 16); *(LAS u32x2*)(Vt + (8 * kch + 2 * e2) * 144 + pos * 2) = ww;
                ww.x = (vreg[0][e2] >> 16) | (vreg[1][e2] & 0xffff0000u); ww.y = (vreg[2][e2] >> 16) | (vreg[3][e2] & 0xffff0000u); *(LAS u32x2*)(Vt + (8 * kch + 2 * e2 + 1) * 144 + pos * 2) = ww; } }
        else if (tid < 192) Bs[tid - 128] = breg;
        __syncthreads();
        const int tn = t - 1; const bool more = tn >= t_lo;
        if (more) FOX_ISSUE(tn);
        if (t <= jd) {
            f32x16 p0, p1;
#pragma unroll
            for (int j = 0; j < 4; ++j) { const f32x4 b0 = *(const LAS f32x4*)(Bs + 8 * j + 4 * hi), b1 = *(const LAS f32x4*)(Bs + 32 + 8 * j + 4 * hi);
                p0[4 * j] = b0.x; p0[4 * j + 1] = b0.y; p0[4 * j + 2] = b0.z; p0[4 * j + 3] = b0.w; p1[4 * j] = b1.x; p1[4 * j + 1] = b1.y; p1[4 * j + 2] = b1.z; p1[4 * j + 3] = b1.w; }
#pragma unroll
            for (int d0 = 0; d0 < 4; ++d0) { const bf16x8 a0 = *(const LAS bf16x8*)(Ks + r32 * 144 + (16 * d0 + 8 * hi) * 2), a1 = *(const LAS bf16x8*)(Ks + (32 + r32) * 144 + (16 * d0 + 8 * hi) * 2);
                p0 = __builtin_amdgcn_mfma_f32_32x32x16_bf16(a0, qr[d0], p0, 0, 0, 0); p1 = __builtin_amdgcn_mfma_f32_32x32x16_bf16(a1, qr[d0], p1, 0, 0, 0); }
            if (t == jd) { const int qg = q0 + 32 * w + r32;
#pragma unroll
                for (int r = 0; r < 16; ++r) { const int kv = 64 * t + crow(r, hi); if (kv > qg) p0[r] = -1e30f; if (kv + 32 > qg) p1[r] = -1e30f; } }
            float mx = fmaxf(p0[0], p1[0]);
#pragma unroll
            for (int r = 1; r < 16; ++r) mx = fmaxf(mx, fmaxf(p0[r], p1[r]));
            mx = fmaxf(mx, __shfl_xor(mx, 32));
            const float m_new = fmaxf(m_run, mx), alpha = exp2f(m_run - m_new);
            float sum = 0.f;
#pragma unroll
            for (int r = 0; r < 16; ++r) { p0[r] = exp2f(p0[r] - m_new); p1[r] = exp2f(p1[r] - m_new); sum += p0[r] + p1[r]; }
            l_run = l_run * alpha + sum; m_run = m_new;
#pragma unroll
            for (int r = 0; r < 16; ++r) { o0[r] *= alpha; o1[r] *= alpha; }
#pragma unroll
            for (int ks = 0; ks < 4; ++ks) {
                u32x4 pw;
                if (ks < 2) { pw.x = pk2(p0[8 * ks], p0[8 * ks + 1]); pw.y = pk2(p0[8 * ks + 2], p0[8 * ks + 3]); pw.z = pk2(p0[8 * ks + 4], p0[8 * ks + 5]); pw.w = pk2(p0[8 * ks + 6], p0[8 * ks + 7]); }
                else { const int k2 = ks - 2; pw.x = pk2(p1[8 * k2], p1[8 * k2 + 1]); pw.y = pk2(p1[8 * k2 + 2], p1[8 * k2 + 3]); pw.z = pk2(p1[8 * k2 + 4], p1[8 * k2 + 5]); pw.w = pk2(p1[8 * k2 + 6], p1[8 * k2 + 7]); }
                const bf16x8 B = __builtin_bit_cast(bf16x8, pw);
                const bf16x8 A0 = *(const LAS bf16x8*)(Vt + r32 * 144 + (16 * ks + 8 * hi) * 2), A1 = *(const LAS bf16x8*)(Vt + (32 + r32) * 144 + (16 * ks + 8 * hi) * 2);
                o0 = __builtin_amdgcn_mfma_f32_32x32x16_bf16(A0, B, o0, 0, 0, 0); o1 = __builtin_amdgcn_mfma_f32_32x32x16_bf16(A1, B, o1, 0, 0, 0);
            }
        }
        if (!more) break;
        t = tn;
    }
#undef FOX_ISSUE
    l_run += __shfl_xor(l_run, 32);
    const float inv = 1.0f / l_run;
    bf16* op = ATT + (size_t)(q0 + 32 * w + r32) * 1024 + 64 * h;
#pragma unroll
    for (int j = 0; j < 4; ++j) { u32x2 w0, w1;
        w0.x = pk2(o0[4 * j] * inv, o0[4 * j + 1] * inv); w0.y = pk2(o0[4 * j + 2] * inv, o0[4 * j + 3] * inv);
        w1.x = pk2(o1[4 * j] * inv, o1[4 * j + 1] * inv); w1.y = pk2(o1[4 * j + 2] * inv, o1[4 * j + 3] * inv);
        *(u32x2*)(op + 8 * j + 4 * hi) = w0; *(u32x2*)(op + 32 + 8 * j + 4 * hi) = w1; }
}

__device__ __forceinline__ void ln_pass(const Ctx& C, float* io, const float* g, const float* b, bf16* Hout, const float* sh, const float* sc) {
    const int gw = C.vcu * 8 + C.wave, NGW = C.G * 8;
    f32x4 gv[4], bv[4], shv[4], scv[4];
#pragma unroll
    for (int j = 0; j < 4; ++j) { gv[j] = ((const f32x4*)g)[64 * j + C.lane]; bv[j] = ((const f32x4*)b)[64 * j + C.lane];
        if (Hout) { shv[j] = ((const f32x4*)sh)[64 * j + C.lane]; scv[j] = ((const f32x4*)sc)[64 * j + C.lane] + 1.0f; } }
    for (int t = gw; t < M; t += NGW) {
        f32x4* xr = (f32x4*)(io + (size_t)t * D) + C.lane;
        f32x4 v[4]; float s = 0.f;
#pragma unroll
        for (int j = 0; j < 4; ++j) { v[j] = xr[64 * j]; s += (v[j].x + v[j].y) + (v[j].z + v[j].w); }
        const float mean = wave_sum(s) * (1.f / D); float s2 = 0.f;
#pragma unroll
        for (int j = 0; j < 4; ++j) { v[j] = v[j] - mean; s2 += (v[j].x * v[j].x + v[j].y * v[j].y) + (v[j].z * v[j].z + v[j].w * v[j].w); }
        const float rstd = 1.f / sqrtf(wave_sum(s2) * (1.f / D) + LN_EPS);
#pragma unroll
        for (int j = 0; j < 4; ++j) { const f32x4 y = v[j] * rstd * gv[j] + bv[j]; xr[64 * j] = y;
            if (Hout) { const f32x4 hh = y * scv[j] + shv[j]; ((unsigned long long*)(Hout + (size_t)t * D))[64 * j + C.lane] = (unsigned long long)pk2(hh.x, hh.y) | ((unsigned long long)pk2(hh.z, hh.w) << 32); } }
    }
}

__global__ void __launch_bounds__(512, 2) mk_fwd(Args args) {
    extern __shared__ __attribute__((aligned(16))) unsigned char lds[];
    Ctx C; C.L = (LAS unsigned char*)lds; C.tid = threadIdx.x; C.lane = C.tid & 63; C.wave = __builtin_amdgcn_readfirstlane(C.tid >> 6);
    C.G = gridDim.x; { const int bx = blockIdx.x; C.vcu = (C.G % 8 == 0) ? (bx % 8) * (C.G / 8) + bx / 8 : bx; }
    unsigned char* ws = args.ws;
    const int lo = args.ph_lo, hi = args.ph_hi;
#define IN(k) (lo <= (k) && (k) < hi)
#define SEAM(k) do { if (IN(k) && IN((k) + 1)) { cg::this_grid().sync(); } } while (0)
    const float* MODF = (const float*)(ws + WS_MODF);
    bf16* H = (bf16*)(ws + WS_H) + 2 * D;

    if (IN(0)) { phase_p0a(C, args); } SEAM(0);
    if (IN(1)) { phase_p0b(C, args); } SEAM(1);
    if (IN(2)) {
        pg8::Gemm g{H, (const bf16*)(ws + WS_WIN), M, NPROJ, D, 256}; pg8::StaticOrder S; S.init(M, NPROJ, C.G, (int)blockIdx.x);
        pg8::EpiBf16<0> E{(bf16*)(ws + WS_FQ), 512, nullptr, 512, (size_t)(16 * MiB) / 2, C2};
        pg8::gemm_phase<pg8::EpiBf16<0>, pg8::StaticOrder, true, true>(C.L, g, S, E);
    } SEAM(2);
    if (IN(3)) { phase_p2a(C, args); } SEAM(3);
    if (IN(4)) { phase_p2b(C, args); } SEAM(4);
    if (IN(5)) {
        for (int u = blockIdx.x; u < 512; u += C.G) fox_unit(C, args, u & 7, 63 - (u >> 3));
        for (int u = blockIdx.x; u < 512; u += C.G) ret_out_unit(C, args, u & 3, u >> 2);
    } SEAM(5);
    if (IN(6)) {
        pg8::Gemm g{(const bf16*)(ws + WS_ATT), (const bf16*)(ws + WS_WO), M, D, D, 256}; pg8::StaticOrder S; S.init(M, D, C.G, (int)blockIdx.x);
        EpiRes E{args.in[0], args.out, MODF + 2 * D, ALPHA_F};
        pg8::gemm_phase<EpiRes, pg8::StaticOrder, true, true>(C.L, g, S, E);
    } SEAM(6);
    if (IN(7)) {
        if (blockIdx.x == 0) { for (int i = C.tid; i < 2 * D / 2; i += 512) ((unsigned*)(ws + WS_H))[i] = 0u; }
        ln_pass(C, args.out, args.in[7], args.in[8], H, MODF + 3 * D, MODF + 4 * D);
    } SEAM(7);
    if (IN(8)) {
        pg8::Gemm g{(const bf16*)(ws + WS_H), (const bf16*)(ws + WS_WUP), M, NUP, D, 254}; pg8::StaticOrder S; S.nM = 65; S.nN = NUP / 256; S.nwg = 65 * (NUP / 256); S.G = C.G; S.c = (int)blockIdx.x;
        EpiGeglu E{(bf16*)(ws + WS_ACT), args.in[10], args.in[11], C.L + XCH_OFF};
        pg8::gemm_phase<EpiGeglu, pg8::StaticOrder, true, true>(C.L, g, S, E);
    } SEAM(8);
    if (IN(9)) {
        pg8::Gemm g{(const bf16*)(ws + WS_ACT), (const bf16*)(ws + WS_WDN), M, D, DFF, 256}; pg8::StaticOrder S; S.init(M, D, C.G, (int)blockIdx.x);
        EpiRes E{args.out, args.out, MODF + 5 * D, ALPHA_F};
        pg8::gemm_phase<EpiRes, pg8::StaticOrder, true, true>(C.L, g, S, E);
    } SEAM(9);
    if (IN(10)) { ln_pass(C, args.out, args.in[13], args.in[14], nullptr, nullptr, nullptr); }
#undef IN
#undef SEAM
}

extern "C" void kernel_launch(void* const* d_in, const int* in_sizes, int n_in, void* d_out, int out_size, void* d_ws, size_t ws_size, hipStream_t stream) {
    static int grid = 0;
    if (grid == 0) {
        if (n_in != 15 || out_size != M * D || ws_size < WS_END) { fprintf(stderr, "kernel_launch: unexpected shapes (n_in %d out %d ws %zu)\n", n_in, out_size, ws_size); grid = -1; return; }
        int dev = 0, cus = 0, per_cu = 0;
        (void)hipGetDevice(&dev); (void)hipDeviceGetAttribute(&cus, hipDeviceAttributeMultiprocessorCount, dev);
        (void)hipFuncSetAttribute((const void*)mk_fwd, hipFuncAttributeMaxDynamicSharedMemorySize, LDS_BYTES);
        (void)hipOccupancyMaxActiveBlocksPerMultiprocessor(&per_cu, (const void*)mk_fwd, 512, LDS_BYTES);
        (void)hipGetLastError();
        if (per_cu < 1) fprintf(stderr, "kernel_launch: occupancy query says %d blocks per CU\n", per_cu);
        grid = cus > 0 ? cus : 256;
    }
    if (grid < 0) return;
    (void)hipMemsetAsync((char*)d_ws + WS_CTL, 0, CTL_BYTES, stream);
    Args a{};
    for (int i = 0; i < 15; ++i) a.in[i] = (const float*)d_in[i];
    a.out = (float*)d_out; a.ws = (unsigned char*)d_ws;
#if MK_PER_PHASE
    for (int p = 0; p < NPH; ++p) { a.ph_lo = p; a.ph_hi = p + 1; hipLaunchKernelGGL(mk_fwd, dim3(grid), dim3(512), LDS_BYTES, stream, a); }
#else
    a.ph_lo = 0; a.ph_hi = NPH;
    void* kargs[] = {&a};
    hipError_t e = hipLaunchCooperativeKernel((const void*)mk_fwd, dim3(grid), dim3(512), kargs, LDS_BYTES, stream);
    if (e != hipSuccess) fprintf(stderr, "cooperative launch failed: %s (grid %d)\n", hipGetErrorString(e), grid);
#endif
}
```

```cpp
#include <hip/hip_runtime.h>
#include <hip/hip_cooperative_groups.h>
#include <cstdio>
#include <cstdint>
namespace cg = cooperative_groups;
namespace pg8 {
#define PG8_LAS __attribute__((address_space(3)))
typedef unsigned short bf16_t;
typedef short bf16x8 __attribute__((ext_vector_type(8)));
typedef float f32x4 __attribute__((ext_vector_type(4)));
typedef unsigned u32x4 __attribute__((ext_vector_type(4)));
constexpr int BM = 256, BK = 64, HALF = 128, HTB = HALF * BK * 2  , STAGE_BYTES = 8 * HTB, NXCD = 8, WGM = 8;

__host__ __device__ __forceinline__ int lds_byte(int r, int c) { const int st = (r >> 4) * 2 + (c >> 5), rr = r & 15, cc = c & 31, ob = rr * 64 + cc * 2; return st * 1024 + (ob ^ (((ob >> 9) & 1) << 5)); }
__host__ __device__ __forceinline__ void stage_rc(int b, int& R, int& C) { const int st = b / 1024, sb = b % 1024, swz = sb ^ (((sb >> 9) & 1) << 5); R = (st >> 1) * 16 + swz / 64; C = (st & 1) * 32 + (swz % 64) / 2; }
__host__ __device__ __forceinline__ int perm32(int rho) { const int n = rho >> 4, i = rho & 15; return 8 * (i >> 2) + 4 * n + (i & 3); }

struct Unit { int pm, pn; };
struct Gemm { const bf16_t* A; const bf16_t* Bt; int M, N, K; int arows; };

struct StaticOrder {
    int nM, nN, nwg, G, c;
    __host__ __device__ void init(int M, int N, int G_, int c_) { nM = M / BM; nN = N / BM; nwg = nM * nN; G = G_; c = c_; }
    __host__ __device__ bool next(int i, Unit& u) const {
        const long L = (long)i * G + c; if (L >= nwg) return false;
        int wgid = (int)L; { const int q = nwg / NXCD, r = nwg % NXCD, xcd = wgid % NXCD, off = wgid / NXCD; wgid = (xcd < r ? xcd * (q + 1) : r * (q + 1) + (xcd - r) * q) + off; }
        const int nig = WGM * nN, gid = wgid / nig, fm = gid * WGM, gsz = (nM - fm) < WGM ? (nM - fm) : WGM;
        u.pm = fm + ((wgid % nig) % gsz); u.pn = (wgid % nig) / gsz; return true;
    }
    __device__ __forceinline__ void a_ready(const Unit&) const {}
    __device__ __forceinline__ void done(const Unit&) const {}
};

__device__ __forceinline__ unsigned cvt_pk_bf16(float lo, float hi) { unsigned r; asm volatile("v_cvt_pk_bf16_f32 %0, %1, %2" : "=v"(r) : "v"(lo), "v"(hi)); return r; }
typedef float f32x2 __attribute__((ext_vector_type(2)));
__device__ __forceinline__ f32x2 gelu_pk(f32x2 v) {
    const f32x2 av = __builtin_elementwise_abs(v), d = av * 0.2316418882f + 1.0f;
    f32x2 t; t.x = __builtin_amdgcn_rcpf(d.x); t.y = __builtin_amdgcn_rcpf(d.y);
    f32x2 q = t * 0.5307027145f + (-0.7265760135f); q = q * t + 0.7107068705f; q = q * t + (-0.142248368f); q = q * t + 0.127414796f; q = q * t;
    const f32x2 s = (v * v) * (-0.72134752044f);
    f32x2 e; e.x = __builtin_amdgcn_exp2f(s.x); e.y = __builtin_amdgcn_exp2f(s.y);
    const f32x2 m = v * (q * e), r = v - m;
    f32x2 o; o.x = v.x < 0.f ? m.x : r.x; o.y = v.y < 0.f ? m.y : r.y; return o;
}

template <int ACT  > struct EpiBf16 {
    static constexpr bool PERM = true, AFTER_DRAIN = false; static_assert(ACT == 0 || ACT == 1, "EpiBf16: ACT is 0 (none) or 1 (gelu_pk)");
    bf16_t* O; int ldc; const float* bias; int split_cols; size_t split_stride; float scale0;
    __device__ __forceinline__ void operator()(const f32x4 (&acc)[2][2][4][2], const Unit& u, int wr, int wc, int fr, int fq) const {
        const int row0 = u.pm * BM + wr * 64 + fr; int colt = u.pn * BM; bf16_t* base = O;
        float sc = 1.f; if (split_cols) { const int t = colt / split_cols; base += (size_t)t * split_stride; colt -= t * split_cols; if (t == 0) sc = scale0; }
        const int col0 = colt + wc * 32 + 8 * fq, bcol0 = u.pn * BM + wc * 32 + 8 * fq;
        f32x4 bv[2][2];
#pragma unroll
        for (int bj = 0; bj < 2; ++bj)
#pragma unroll
            for (int n = 0; n < 2; ++n) bv[bj][n] = bias ? *(const f32x4*)(bias + bcol0 + bj * HALF + 4 * n) : (f32x4){0.f, 0.f, 0.f, 0.f};
#pragma unroll
        for (int ai = 0; ai < 2; ++ai)
#pragma unroll
            for (int m = 0; m < 4; ++m) { bf16_t* rowp = base + (size_t)(row0 + ai * HALF + m * 16) * ldc + col0;
#pragma unroll
                for (int bj = 0; bj < 2; ++bj) { f32x4 v0 = acc[ai][bj][m][0] + bv[bj][0], v1 = acc[ai][bj][m][1] + bv[bj][1];
                    if (ACT == 1) { f32x2 a = gelu_pk((f32x2){v0[0], v0[1]}), b = gelu_pk((f32x2){v0[2], v0[3]}), c = gelu_pk((f32x2){v1[0], v1[1]}), d = gelu_pk((f32x2){v1[2], v1[3]});
                        v0 = (f32x4){a.x, a.y, b.x, b.y}; v1 = (f32x4){c.x, c.y, d.x, d.y}; }
                    v0 = v0 * sc; v1 = v1 * sc; u32x4 w; w.x = cvt_pk_bf16(v0[0], v0[1]); w.y = cvt_pk_bf16(v0[2], v0[3]); w.z = cvt_pk_bf16(v1[0], v1[1]); w.w = cvt_pk_bf16(v1[2], v1[3]);
                    *(u32x4*)(rowp + bj * HALF) = w; } }
    }
};

template <class Epi, class Sched, bool ALIGN_EPI = false, bool SP2 = false>
__device__ __forceinline__ void gemm_phase(PG8_LAS unsigned char* lds, const Gemm g, const Sched& S, const Epi& E) {
    const int tid = threadIdx.x, wid = __builtin_amdgcn_readfirstlane(tid >> 6), lane = tid & 63, wr = wid >> 2, wc = wid & 3, fr = lane & 15, fq = lane >> 4;
    const int K = g.K, nt = K / BK;
    unsigned voffA[2], voffB[2];
#pragma unroll
    for (int i = 0; i < 2; ++i) { int R, C; stage_rc(tid * 16 + i * 8192, R, C); const int Rb = Epi::PERM ? ((R & ~31) + perm32(R & 31)) : R;
        voffA[i] = (unsigned)(R * K + C) * 2u; voffB[i] = (unsigned)(Rb * K + C) * 2u; }
    const size_t kstep = (size_t)(BK * 2);
    const size_t hstep = (size_t)HALF * K * 2;
    const size_t tstep = 2 * hstep; const size_t astep = (size_t)g.arows * K * 2;
    const unsigned ldsw = (unsigned)wid * 1024u;
    const int aoff = lds_byte(wr * 64 + fr, fq * 8), boff = lds_byte(wc * 32 + fr, fq * 8);
#define PG8_SA(b, h) (((b) * 2 + (h)) * HTB)
#define PG8_SB(b, h) ((4 + (b) * 2 + (h)) * HTB)
#define PG8_STAGE(bufoff, gbase, voff) do { _Pragma("unroll") for (int _i = 0; _i < 2; ++_i) \
        __builtin_amdgcn_global_load_lds((const unsigned*)((const char*)(gbase) + (voff)[_i]), (PG8_LAS unsigned*)(lds + (bufoff) + ldsw + _i * 8192), 16, 0, 0); } while (0)
#define PG8_LDA(dst, b, h) do { _Pragma("unroll") for (int m = 0; m < 4; ++m) _Pragma("unroll") for (int k = 0; k < 2; ++k) dst[m][k] = *(const PG8_LAS bf16x8*)(lds + PG8_SA(b, h) + aoff + m * 2048 + k * 1024); } while (0)
#define PG8_LDB(dst, b, h) do { _Pragma("unroll") for (int n = 0; n < 2; ++n) _Pragma("unroll") for (int k = 0; k < 2; ++k) dst[n][k] = *(const PG8_LAS bf16x8*)(lds + PG8_SB(b, h) + boff + n * 2048 + k * 1024); } while (0)
#define PG8_MMA(ai, bj, At, Bt) do { __builtin_amdgcn_s_setprio(1); _Pragma("unroll") for (int m = 0; m < 4; ++m) _Pragma("unroll") for (int n = 0; n < 2; ++n) _Pragma("unroll") for (int k = 0; k < 2; ++k) \
        acc[ai][bj][m][n] = __builtin_amdgcn_mfma_f32_16x16x32_bf16(Bt[n][k], At[m][k], acc[ai][bj][m][n], 0, 0, 0); __builtin_amdgcn_s_setprio(0); } while (0)
#define PG8_WAIT_V(n) asm volatile("s_waitcnt vmcnt(" #n ")" ::: "memory")
#define PG8_WAIT_L(n) asm volatile("s_waitcnt lgkmcnt(" #n ")" ::: "memory")
#define PG8_BAR __builtin_amdgcn_s_barrier()
#define PG8_SCHED __builtin_amdgcn_sched_barrier(0)
    Unit cur, nxt; int ui = 0;
    if (!S.next(0, cur)) return;
    f32x4 acc[2][2][4][2];
#pragma unroll
    for (int a = 0; a < 2; ++a)
#pragma unroll
        for (int b = 0; b < 2; ++b)
#pragma unroll
            for (int m = 0; m < 4; ++m)
#pragma unroll
                for (int n = 0; n < 2; ++n) acc[a][b][m][n] = (f32x4){0.f, 0.f, 0.f, 0.f};
    bf16x8 At[4][2], B0[2][2], B1[2][2];
    const char* cA = (const char*)g.A + (size_t)cur.pm * astep; const char* cB = (const char*)g.Bt + (size_t)cur.pn * tstep;
    S.a_ready(cur);
    if constexpr (SP2) {
        PG8_STAGE(PG8_SB(0, 0), cB, voffB); PG8_STAGE(PG8_SB(0, 1), cB + hstep, voffB); PG8_STAGE(PG8_SA(0, 0), cA, voffA); PG8_STAGE(PG8_SA(0, 1), cA + hstep, voffA);
        if (wr == 1) PG8_BAR;
        PG8_WAIT_V(2); PG8_BAR;
        PG8_STAGE(PG8_SB(1, 0), cB + kstep, voffB); PG8_STAGE(PG8_SA(1, 0), cA + kstep, voffA); PG8_STAGE(PG8_SB(1, 1), cB + hstep + kstep, voffB);
        PG8_WAIT_V(6); PG8_BAR;
    } else {
        PG8_STAGE(PG8_SB(0, 0), cB, voffB); PG8_STAGE(PG8_SA(0, 0), cA, voffA); PG8_STAGE(PG8_SB(0, 1), cB + hstep, voffB); PG8_STAGE(PG8_SA(0, 1), cA + hstep, voffA);
        if (wr == 1) PG8_BAR;
        PG8_WAIT_V(4); PG8_BAR;
        PG8_STAGE(PG8_SB(1, 0), cB + kstep, voffB); PG8_STAGE(PG8_SA(1, 0), cA + kstep, voffA); PG8_STAGE(PG8_SB(1, 1), cB + hstep + kstep, voffB);
        PG8_WAIT_V(6); PG8_BAR;
    }
    for (;;) {
        const bool has_next = S.next(ui + 1, nxt);
        const char* nA = has_next ? (const char*)g.A + (size_t)nxt.pm * astep : cA; const char* nB = has_next ? (const char*)g.Bt + (size_t)nxt.pn * tstep : cB;
        for (int t = 0; t < nt; t += 2) {
            const bool last = (t == nt - 2);
            const char* a1 = cA + (size_t)(t + 1) * kstep;
            const char* a2 = last ? nA : cA + (size_t)(t + 2) * kstep; const char* b2 = last ? nB : cB + (size_t)(t + 2) * kstep;
            const char* a3 = a2 + kstep; const char* b3 = b2 + kstep;
            if (last && has_next) S.a_ready(nxt);
            if constexpr (SP2) {
            PG8_LDB(B0, 0, 0); PG8_LDB(B1, 0, 1); PG8_SCHED; PG8_LDA(At, 0, 0); PG8_STAGE(PG8_SA(1, 1), a1 + hstep, voffA);
            PG8_WAIT_V(8); PG8_WAIT_L(0); PG8_BAR; PG8_MMA(0, 0, At, B0); PG8_MMA(0, 1, At, B1); PG8_BAR; PG8_SCHED;
            PG8_LDA(At, 0, 1); PG8_STAGE(PG8_SB(0, 0), b2, voffB); PG8_STAGE(PG8_SB(0, 1), b2 + hstep, voffB); PG8_STAGE(PG8_SA(0, 0), a2, voffA);
            PG8_WAIT_V(8); PG8_WAIT_L(0); PG8_BAR; PG8_MMA(1, 0, At, B0); PG8_MMA(1, 1, At, B1); PG8_BAR; PG8_SCHED;
            PG8_LDB(B0, 1, 0); PG8_LDB(B1, 1, 1); PG8_SCHED; PG8_LDA(At, 1, 0); PG8_STAGE(PG8_SA(0, 1), a2 + hstep, voffA);
            PG8_WAIT_V(8); PG8_WAIT_L(0); PG8_BAR; PG8_MMA(0, 0, At, B0); PG8_MMA(0, 1, At, B1); PG8_BAR; PG8_SCHED;
            PG8_LDA(At, 1, 1); PG8_STAGE(PG8_SB(1, 0), b3, voffB); PG8_STAGE(PG8_SB(1, 1), b3 + hstep, voffB); PG8_STAGE(PG8_SA(1, 0), a3, voffA);
            PG8_WAIT_V(8); PG8_WAIT_L(0); PG8_BAR; PG8_MMA(1, 0, At, B0); PG8_MMA(1, 1, At, B1); PG8_BAR; PG8_SCHED;
            } else {
            PG8_LDB(B0, 0, 0); PG8_SCHED; PG8_LDA(At, 0, 0); PG8_STAGE(PG8_SA(1, 1), a1 + hstep, voffA);
            PG8_WAIT_L(8); PG8_BAR; PG8_WAIT_L(0); PG8_MMA(0, 0, At, B0); PG8_BAR; PG8_SCHED;
            PG8_LDB(B1, 0, 1); PG8_STAGE(PG8_SB(0, 0), b2, voffB);
            PG8_BAR; PG8_WAIT_L(0); PG8_MMA(0, 1, At, B1); PG8_BAR;
            PG8_LDA(At, 0, 1); PG8_STAGE(PG8_SA(0, 0), a2, voffA);
            PG8_BAR; PG8_WAIT_L(0); PG8_MMA(1, 0, At, B0); PG8_BAR; PG8_SCHED;
            PG8_STAGE(PG8_SB(0, 1), b2 + hstep, voffB);
            PG8_WAIT_V(6); PG8_BAR; PG8_MMA(1, 1, At, B1); PG8_BAR;
            PG8_LDB(B0, 1, 0); PG8_SCHED; PG8_LDA(At, 1, 0); PG8_STAGE(PG8_SA(0, 1), a2 + hstep, voffA);
            PG8_WAIT_L(8); PG8_BAR; PG8_WAIT_L(0); PG8_MMA(0, 0, At, B0); PG8_BAR; PG8_SCHED;
            PG8_LDB(B1, 1, 1); PG8_STAGE(PG8_SB(1, 0), b3, voffB);
            PG8_BAR; PG8_WAIT_L(0); PG8_MMA(0, 1, At, B1); PG8_BAR;
            PG8_LDA(At, 1, 1); PG8_STAGE(PG8_SA(1, 0), a3, voffA);
            PG8_BAR; PG8_WAIT_L(0); PG8_MMA(1, 0, At, B0); PG8_BAR; PG8_SCHED;
            PG8_STAGE(PG8_SB(1, 1), b3 + hstep, voffB);
            PG8_WAIT_V(6); PG8_BAR; PG8_MMA(1, 1, At, B1); PG8_BAR;
            }
        }
        if constexpr (ALIGN_EPI) { if (wr == 0) PG8_BAR; }
        if constexpr (!Epi::AFTER_DRAIN) { E(acc, cur, wr, wc, fr, fq); S.done(cur); }
        if (!has_next) break;
#pragma unroll
        for (int a = 0; a < 2; ++a)
#pragma unroll
            for (int b = 0; b < 2; ++b)
#pragma unroll
                for (int m = 0; m < 4; ++m)
#pragma unroll
                    for (int n = 0; n < 2; ++n) acc[a][b][m][n] = (f32x4){0.f, 0.f, 0.f, 0.f};
        cur = nxt; cA = nA; cB = nB; ++ui;
        if constexpr (ALIGN_EPI) { if (wr == 1) PG8_BAR; }
    }
    PG8_WAIT_V(0);
    if constexpr (!ALIGN_EPI) { if (wr == 0) PG8_BAR; }
    PG8_BAR;
    if constexpr (Epi::AFTER_DRAIN) { E.fused(acc, cur, wr, wc, fr, fq, lds, wid, lane); S.done(cur); }
#undef PG8_SA
#undef PG8_SB
#undef PG8_STAGE
#undef PG8_LDA
#undef PG8_LDB
#undef PG8_MMA
#undef PG8_WAIT_V
#undef PG8_WAIT_L
#undef PG8_BAR
#undef PG8_SCHED
}
}

#ifndef MK_PER_PHASE
#define MK_PER_PHASE 0
#endif
#ifndef PROBE_DUP
#define PROBE_DUP 0
#endif
#define LAS __attribute__((address_space(3)))
typedef unsigned short bf16;
typedef float f32x4 __attribute__((ext_vector_type(4)));
typedef float f32x2 __attribute__((ext_vector_type(2)));
typedef float f32x16 __attribute__((ext_vector_type(16)));
typedef unsigned u32x4 __attribute__((ext_vector_type(4)));
typedef unsigned u32x2 __attribute__((ext_vector_type(2)));
typedef short bf16x8 __attribute__((ext_vector_type(8)));

constexpr int M = 16384, D = 1024, NPROJ = 3584, INC = 3592, DFF = 2816, NUP = 5632, NMOD = 6144;
constexpr float ALPHA_F = 1.18920711500272f;
constexpr float LN_EPS = 1e-5f, GN_EPS = 1e-6f;
constexpr float LOG2E = 1.4426950408889634f;
constexpr float C2 = 0.125f * LOG2E;
constexpr int NPH = 11;
constexpr int NSL = 32;

constexpr size_t MiB = 1u << 20;
constexpr size_t WS_CTL = 0, CTL_BYTES = 65536;
constexpr int CW_BAR = 1024;
constexpr int BARLDS_OFF = 143360;
constexpr size_t WS_MODF = 64 * 1024;
constexpr size_t WS_PART = 1 * MiB;
constexpr size_t WS_WIN = 2 * MiB, WS_WO = 9 * MiB, WS_WUP = 11 * MiB, WS_WDN = 22 * MiB;
constexpr size_t WS_CS = 28 * MiB;
constexpr size_t WS_LOGF = 36 * MiB;
constexpr size_t WS_CB = 37 * MiB;
constexpr size_t WS_H = 38 * MiB;
constexpr size_t WS_RT = 38 * MiB;
constexpr size_t WS_FQ = 71 * MiB;
constexpr size_t WS_ATT = 183 * MiB;
constexpr size_t WS_KV = 215 * MiB;
constexpr size_t WS_ACT = 71 * MiB;
constexpr size_t WS_END = 256 * MiB;
constexpr int LDS_BYTES = 147456;
constexpr int XCH_OFF = 131072;

#define LDS_WAIT() asm volatile("s_waitcnt lgkmcnt(0)" ::: "memory")
__device__ __forceinline__ unsigned f2bf(float f) { unsigned u = __builtin_bit_cast(unsigned, f); return (u + 0x7fffu + ((u >> 16) & 1u)) >> 16; }
typedef __bf16 bf16x2_t __attribute__((ext_vector_type(2)));
__device__ __forceinline__ unsigned pk2(float lo, float hi) { f32x2 v = {lo, hi}; bf16x2_t b = __builtin_convertvector(v, bf16x2_t); return __builtin_bit_cast(unsigned, b); }
__device__ __forceinline__ float bflo(unsigned w) { return __builtin_bit_cast(float, w << 16); }
__device__ __forceinline__ float bfhi(unsigned w) { return __builtin_bit_cast(float, w & 0xffff0000u); }
__device__ __forceinline__ int crow(int r, int hi) { return (r & 3) + 8 * (r >> 2) + 4 * hi; }
__device__ __forceinline__ float wave_sum(float v) {
#pragma unroll
    for (int o = 1; o < 64; o <<= 1) v += __shfl_xor(v, o);
    return v;
}
__device__ __forceinline__ int kvpos(int m0) { return 16 * (m0 >> 4) + 8 * ((m0 >> 2) & 1) + 4 * ((m0 >> 3) & 1); }
template <int CTRL> __device__ __forceinline__ float dppz(float v) { return __builtin_bit_cast(float, __builtin_amdgcn_update_dpp(0, __builtin_bit_cast(int, v), CTRL, 0xF, 0xF, true)); }

struct EpiRes {
    static constexpr bool PERM = false, AFTER_DRAIN = false;
    const float* X; float* out; const float* gate; float alpha;
    __device__ __forceinline__ void operator()(const pg8::f32x4 (&acc)[2][2][4][2], const pg8::Unit& u, int wr, int wc, int fr, int fq) const {
        const int col0 = u.pn * 256 + wc * 32 + 4 * fq;
        f32x4 gv[2][2];
#pragma unroll
        for (int bj = 0; bj < 2; ++bj)
#pragma unroll
            for (int n = 0; n < 2; ++n) gv[bj][n] = *(const f32x4*)(gate + col0 + bj * 128 + n * 16);
#pragma unroll
        for (int ai = 0; ai < 2; ++ai)
#pragma unroll
            for (int m = 0; m < 4; ++m) { const size_t off = (size_t)(u.pm * 256 + ai * 128 + wr * 64 + m * 16 + fr) * D + col0;
#pragma unroll
                for (int bj = 0; bj < 2; ++bj)
#pragma unroll
                    for (int n = 0; n < 2; ++n) { const f32x4 xv = *(const f32x4*)(X + off + bj * 128 + n * 16);
                        const f32x4 o = xv * alpha + gv[bj][n] * acc[ai][bj][m][n]; *(f32x4*)(out + off + bj * 128 + n * 16) = o; }
                if (m & 1) asm volatile("" ::: "memory"); }
    }
};
struct EpiGeglu {
    static constexpr bool PERM = true, AFTER_DRAIN = false;
    bf16* act; const float* cw; const float* cbias; LAS unsigned char* xch;
    __device__ __forceinline__ void operator()(const pg8::f32x4 (&acc)[2][2][4][2], const pg8::Unit& u, int wr, int wc, int fr, int fq) const {
        if (fr >= 14) {
#pragma unroll
            for (int ai = 0; ai < 2; ++ai)
#pragma unroll
                for (int bj = 0; bj < 2; ++bj)
#pragma unroll
                    for (int n = 0; n < 2; ++n)
                        *(LAS f32x4*)(xch + ((((ai * 2 + wr) * 2 + (fr - 14)) * 256) + bj * 128 + wc * 32 + 8 * fq + 4 * n) * 4) = acc[ai][bj][3][n];
        }
        asm volatile("s_waitcnt lgkmcnt(0)" ::: "memory"); __builtin_amdgcn_s_barrier(); asm volatile("" ::: "memory");
        const int ca0 = u.pn * 128 + wc * 32 + 8 * fq;
        u32x2 keep[2][4];
#pragma unroll
        for (int n = 0; n < 2; ++n) {
            const int ca = ca0 + 4 * n;
            const f32x4 wa0 = *(const f32x4*)(cw + ca), wa1 = *(const f32x4*)(cw + NUP + ca), wa2 = *(const f32x4*)(cw + 2 * NUP + ca), ba = *(const f32x4*)(cbias + ca);
            const f32x4 wb0 = *(const f32x4*)(cw + DFF + ca), wb1 = *(const f32x4*)(cw + NUP + DFF + ca), wb2 = *(const f32x4*)(cw + 2 * NUP + DFF + ca), bb = *(const f32x4*)(cbias + DFF + ca);
#pragma unroll
            for (int ai = 0; ai < 2; ++ai) {
                f32x4 pa = (f32x4){0.f, 0.f, 0.f, 0.f}, pb = pa;
                const int pai = wr ? ai : ai - 1, pwr = wr ? 0 : 1;
                if (pai >= 0 && fr >= 14) {
                    pa = *(const LAS f32x4*)(xch + ((((pai * 2 + pwr) * 2 + (fr - 14)) * 256) + 0 * 128 + wc * 32 + 8 * fq + 4 * n) * 4);
                    pb = *(const LAS f32x4*)(xch + ((((pai * 2 + pwr) * 2 + (fr - 14)) * 256) + 1 * 128 + wc * 32 + 8 * fq + 4 * n) * 4);
                }
#pragma unroll
                for (int m = 0; m < 4; ++m) {
                    const f32x4 ca_ = acc[ai][0][m][n], cb_ = acc[ai][1][m][n];
                    const f32x4 qa = m ? acc[ai][0][m - 1][n] : pa, qb = m ? acc[ai][1][m - 1][n] : pb;
                    float ya[4], yb[4];
#pragma unroll
                    for (int i = 0; i < 4; ++i) {
                        const float a1 = dppz<0x111>(ca_[i]) + dppz<0x10F>(qa[i]);
                        const float a2 = dppz<0x112>(ca_[i]) + dppz<0x10E>(qa[i]);
                        const float b1 = dppz<0x111>(cb_[i]) + dppz<0x10F>(qb[i]);
                        const float b2 = dppz<0x112>(cb_[i]) + dppz<0x10E>(qb[i]);
                        ya[i] = ba[i] + wa2[i] * ca_[i] + wa1[i] * a1 + wa0[i] * a2;
                        yb[i] = bb[i] + wb2[i] * cb_[i] + wb1[i] * b1 + wb0[i] * b2;
                    }
                    const pg8::f32x2 g0 = pg8::gelu_pk((pg8::f32x2){ya[0], ya[1]}), g1 = pg8::gelu_pk((pg8::f32x2){ya[2], ya[3]});
                    u32x2 w; w.x = pg8::cvt_pk_bf16(g0.x * yb[0], g0.y * yb[1]); w.y = pg8::cvt_pk_bf16(g1.x * yb[2], g1.y * yb[3]);
                    if (n == 0) keep[ai][m] = w;
                    else {
                        const int row = ai * 128 + wr * 64 + m * 16 + fr, t = u.pm * 254 - 2 + row;
                        if (row >= 2 && t < M) { u32x4 o; o.x = keep[ai][m].x; o.y = keep[ai][m].y; o.z = w.x; o.w = w.y; *(u32x4*)(act + (size_t)t * DFF + ca0) = o; }
                    }
                }
            }
        }
    }
};

#define RLX_AGENT __ATOMIC_RELAXED, __HIP_MEMORY_SCOPE_AGENT
#define XB_TMO      128
#define XB_XCNT(j)  (256  + 64 * (j))
#define XB_XSUB(j)  (1280 + 64 * (j))
#define XB_XGEN(j)  (2304 + 64 * (j))
#define XB_TOP      3328
#define XB_TOPGEN   3392
#define XCD_BAR_WORDS 3456
#define XB_SPIN_CAP (1u << 18)

__device__ __forceinline__ unsigned xb_ld(unsigned* p)              { return __hip_atomic_load(p, __ATOMIC_RELAXED, __HIP_MEMORY_SCOPE_AGENT); }
__device__ __forceinline__ unsigned xb_add(unsigned* p, unsigned v) { return __hip_atomic_fetch_add(p, v, __ATOMIC_RELAXED, __HIP_MEMORY_SCOPE_AGENT); }
__device__ __forceinline__ unsigned xb_xcc_id() { return (unsigned)__builtin_amdgcn_s_getreg((3 << 11) | 20) & 0xFu; }
#define XB_SPIN(cond, bar) do { unsigned _sp = 0; while (cond) { __builtin_amdgcn_s_sleep(1); \
    if ((++_sp & 255u) == 0u) { if (xb_ld(&(bar)[XB_TMO])) break; if (_sp > XB_SPIN_CAP) { atomicAdd(&(bar)[XB_TMO], 1u); break; } } } } while (0)

struct XcdBarrier {
    unsigned* bar; unsigned x;
    volatile LAS unsigned* st;
};

__device__ __forceinline__ XcdBarrier xcd_barrier_post(unsigned* bar, volatile LAS unsigned* st) {
    XcdBarrier b; b.bar = bar; b.x = xb_xcc_id(); b.st = st;
    if (threadIdx.x == 0) (void)xb_add(&bar[XB_XCNT(b.x)], 1u);
    return b;
}
__device__ __forceinline__ void xcd_barrier_complete(unsigned* bar, unsigned x, unsigned& nloc, unsigned& nx) {
    const unsigned G = gridDim.x * gridDim.y * gridDim.z;
    unsigned sum, cnt, mine, sp = 0u;
    for (;;) {
        sum = 0u; cnt = 0u; mine = 0u;
#pragma unroll
        for (unsigned j = 0; j < 16; ++j) { const unsigned c = xb_ld(&bar[XB_XCNT(j)]); sum += c; cnt += (c > 0u) ? 1u : 0u; mine = (j == x) ? c : mine; }
        if (sum == G) break;
        __builtin_amdgcn_s_sleep(1);
        if ((++sp & 255u) == 0u) { if (xb_ld(&bar[XB_TMO])) break; if (sp > XB_SPIN_CAP) { atomicAdd(&bar[XB_TMO], 1u); break; } }
    }
    nloc = mine > 0u ? mine : 1u; nx = cnt > 0u ? cnt : 1u;
}

__device__ __forceinline__ void xcd_barrier(const XcdBarrier& b) {
    asm volatile("s_waitcnt vmcnt(0)" ::: "memory");
    __syncthreads();
    if (threadIdx.x == 0) {
        unsigned* bar = b.bar;
        __builtin_amdgcn_s_waitcnt(0);
        unsigned nloc = b.st[0], nx = b.st[1];
        if (nloc == 0u) { xcd_barrier_complete(bar, b.x, nloc, nx); b.st[0] = nloc; b.st[1] = nx; }
        const unsigned old = xb_add(&bar[XB_XSUB(b.x)], 1u);
        const unsigned gen = old / nloc;
        if (old + 1u == (gen + 1u) * nloc) {
            __builtin_amdgcn_fence(__ATOMIC_RELEASE, "agent");
            asm volatile("s_waitcnt vmcnt(0)" ::: "memory");
            const unsigned og = xb_add(&bar[XB_TOP], 1u);
            const unsigned tg = og / nx;
            if (og + 1u == (tg + 1u) * nx) xb_add(&bar[XB_TOPGEN], 1u);
            else XB_SPIN(xb_ld(&bar[XB_TOPGEN]) == tg, bar);
            __builtin_amdgcn_fence(__ATOMIC_ACQUIRE, "agent");
            xb_add(&bar[XB_XGEN(b.x)], 1u);
            asm volatile("s_waitcnt vmcnt(0)" ::: "memory");
        } else {
            XB_SPIN(xb_ld(&bar[XB_XGEN(b.x)]) == gen, bar);
            __builtin_amdgcn_fence(__ATOMIC_ACQUIRE, "agent");
            asm volatile("s_waitcnt vmcnt(0)" ::: "memory");
        }
    }
    __syncthreads();
}

struct Args { const float* in[15]; float* out; unsigned char* ws; int ph_lo, ph_hi; };

struct Ctx {
    LAS unsigned char* L; int tid, lane, wave, G, vcu;
};

__device__ __forceinline__ void tr_item(const float* W, int ldw, int src_col0, int k0, bf16* WT, int K, int dst_row0, LAS float* scr, int lane) {
#pragma unroll 8
    for (int i = 0; i < 32; ++i) { const int kk = 2 * i + (lane >> 5); scr[kk * 33 + (lane & 31)] = W[(size_t)(k0 + kk) * ldw + src_col0 + (lane & 31)]; }
    LDS_WAIT(); asm volatile("" ::: "memory");
    const int c = lane & 7;
#pragma unroll
    for (int j = 0; j < 4; ++j) { const int n = (lane >> 3) + 8 * j; const LAS float* s = scr + (8 * c) * 33 + n;
        u32x4 o; o.x = pk2(s[0 * 33], s[1 * 33]); o.y = pk2(s[2 * 33], s[3 * 33]); o.z = pk2(s[4 * 33], s[5 * 33]); o.w = pk2(s[6 * 33], s[7 * 33]);
        *(u32x4*)(WT + (size_t)(dst_row0 + n) * K + k0 + 8 * c) = o; }
    LDS_WAIT(); asm volatile("" ::: "memory");
}

__device__ __forceinline__ void phase_p0a(const Ctx& C, const Args& a) {
    unsigned char* ws = a.ws;
    const float* cvec = a.in[1]; const float* w_ada = a.in[2];
    if ((int)blockIdx.x < NSL * 3) {
        const int s = blockIdx.x / 3, cgp = blockIdx.x % 3, col4 = cgp * 512 + C.tid;
        f32x4 acc = (f32x4){0.f, 0.f, 0.f, 0.f};
        for (int i = 32 * s; i < 32 * s + 32; ++i) { const float cv = cvec[i]; const float sv = cv / (1.f + __expf(-cv));
            const f32x4 w = *(const f32x4*)(w_ada + (size_t)i * NMOD + 4 * col4); acc += w * sv; }
        *(f32x4*)((float*)(ws + WS_PART) + (size_t)s * NMOD + 4 * col4) = acc;
    }
    { f32x2* CS = (f32x2*)(ws + WS_CS); const int gt = C.vcu * 512 + C.tid, NT = C.G * 512;
      for (int idx = gt; idx < M * 64; idx += NT) { const int t = idx >> 6, i = idx & 63;
          const float inv = powf(10000.f, -(float)i / 64.f); const float ang = (float)t * inv;
          const double ad = (double)ang; const double rev = ad * 0.15915494309189535; const double fr = rev - rint(rev);
          const float rad = (float)(fr * 6.283185307179586);
          CS[idx] = (f32x2){__cosf(rad), __sinf(rad)}; } }
    LAS float* scr = (LAS float*)(C.L + C.wave * 16384);
    const int gw = C.vcu * 8 + C.wave, NGW = C.G * 8;
    constexpr int I_IN = 16 * 112, I_O = 16 * 32, I_UP = 16 * 176, I_DN = 44 * 32, NIT = I_IN + I_O + I_UP + I_DN;
    bf16* Win = (bf16*)(ws + WS_WIN); bf16* Wo = (bf16*)(ws + WS_WO); bf16* Wup = (bf16*)(ws + WS_WUP); bf16* Wdn = (bf16*)(ws + WS_WDN);
    for (int it = gw; it < NIT; it += NGW) {
        int r = it;
        if (r < I_IN) { const int kb = r / 112, nb = r % 112, n0 = 32 * nb; tr_item(a.in[4], INC, n0 < 1536 ? n0 : n0 + 8, 64 * kb, Win, D, n0, scr, C.lane); continue; } r -= I_IN;
        if (r < I_O) { const int kb = r / 32, nb = r % 32; tr_item(a.in[6], D, 32 * nb, 64 * kb, Wo, D, 32 * nb, scr, C.lane); continue; } r -= I_O;
        if (r < I_UP) { const int kb = r / 176, nb = r % 176, n0 = 32 * nb, pn = n0 >> 8, rr = n0 & 255; const int src = rr < 128 ? 128 * pn + rr : DFF + 128 * pn + (rr - 128);
            tr_item(a.in[9], NUP, src, 64 * kb, Wup, D, n0, scr, C.lane); continue; } r -= I_UP;
        { const int kb = r / 32, nb = r % 32; tr_item(a.in[12], D, 32 * nb, 64 * kb, Wdn, DFF, 32 * nb, scr, C.lane); }
    }
}

__device__ __forceinline__ void phase_p0b(const Ctx& C, const Args& a) {
    unsigned char* ws = a.ws;
    const float* part = (const float*)(ws + WS_PART); const float* b_ada = a.in[3];
    LAS float* modl = (LAS float*)C.L;
    LAS float* wff = (LAS float*)(C.L + 8192);
    const int nv4 = (blockIdx.x == 0) ? NMOD / 4 : 512;
    for (int v4 = C.tid; v4 < nv4; v4 += 512) { f32x4 s = ((const f32x4*)b_ada)[v4];
#pragma unroll 16
        for (int k = 0; k < NSL; ++k) s += ((const f32x4*)part)[(size_t)k * (NMOD / 4) + v4];
        if (v4 < 512) *(LAS f32x4*)(modl + 4 * v4) = s;
        if (blockIdx.x == 0) ((f32x4*)(ws + WS_MODF))[v4] = s; }
    const float* w_in = a.in[4];
    for (int e = C.tid; e < 8192; e += 512) wff[e] = w_in[(size_t)(e >> 3) * INC + 1536 + (e & 7)];
    __syncthreads();
    const float* x = a.in[0]; const float* b_f = a.in[5];
    bf16* H = (bf16*)(ws + WS_H) + 2 * D; float* LOGF = (float*)(ws + WS_LOGF);
    const int gw = C.vcu * 8 + C.wave, NGW = C.G * 8;
    for (int t = gw; t < M; t += NGW) {
        const f32x4* xr = (const f32x4*)(x + (size_t)t * D) + C.lane;
        float pf[8];
#pragma unroll
        for (int f = 0; f < 8; ++f) pf[f] = 0.f;
        unsigned long long* o8 = (unsigned long long*)(H + (size_t)t * D) + C.lane;
#pragma unroll
        for (int j = 0; j < 4; ++j) {
            const f32x4 xv = xr[64 * j]; const int c0 = 256 * j + 4 * C.lane;
            const f32x4 sh = *(const LAS f32x4*)(modl + c0), sc = *(const LAS f32x4*)(modl + 1024 + c0);
            const f32x4 hv = xv * (sc + 1.0f) + sh;
            o8[64 * j] = (unsigned long long)pk2(hv.x, hv.y) | ((unsigned long long)pk2(hv.z, hv.w) << 32);
#pragma unroll
            for (int e = 0; e < 4; ++e) { const f32x4 w0 = *(const LAS f32x4*)(wff + (c0 + e) * 8), w1 = *(const LAS f32x4*)(wff + (c0 + e) * 8 + 4);
                const float hh = hv[e];
                pf[0] += hh * w0.x; pf[1] += hh * w0.y; pf[2] += hh * w0.z; pf[3] += hh * w0.w; pf[4] += hh * w1.x; pf[5] += hh * w1.y; pf[6] += hh * w1.z; pf[7] += hh * w1.w; }
        }
#pragma unroll
        for (int f = 0; f < 8; ++f) pf[f] = wave_sum(pf[f]);
        float z = pf[0];
#pragma unroll
        for (int f = 1; f < 8; ++f) z = (C.lane == f) ? pf[f] : z;
        if (C.lane < 8) { z += b_f[C.lane]; const float lf = fminf(z, 0.f) - log1pf(__expf(-fabsf(z))); LOGF[(size_t)C.lane * M + t] = lf; }
    }
}

__device__ __forceinline__ float lg2gamma(int h) { return log2f(1.0f - exp2f(-5.0f - (float)h)); }

__device__ __forceinline__ void ret_kv_unit(const Ctx& C, const Args& a, int h, int ck) {
    unsigned char* ws = a.ws;
    const bf16* RK = (const bf16*)(ws + WS_FQ + 4 * 16 * MiB); const bf16* RV = (const bf16*)(ws + WS_FQ + 5 * 16 * MiB);
    const f32x2* CS = (const f32x2*)(ws + WS_CS); float* KV = (float*)(ws + WS_KV);
    LAS unsigned char* Kt = C.L; LAS unsigned char* Vt = C.L + 34816;
    const int t0 = 128 * ck; const float lg = lg2gamma(h);
    __syncthreads();
    if (C.tid < 256) {
        const int tg = C.tid >> 3, dc = C.tid & 7;
        unsigned lo[4][4], hi_[4][4];
#pragma unroll
        for (int tt = 0; tt < 4; ++tt) { const int m = 4 * tg + tt, t = t0 + m;
            const u32x4 klo = *(const u32x4*)(RK + (size_t)t * 512 + 128 * h + 8 * dc), khi = *(const u32x4*)(RK + (size_t)t * 512 + 128 * h + 64 + 8 * dc);
            const float sc = 0.08838834764831845f * exp2f((float)(127 - m) * lg);
            const f32x4* cs4 = (const f32x4*)(CS + (size_t)t * 64 + 8 * dc);
#pragma unroll
            for (int e2 = 0; e2 < 4; ++e2) { const f32x4 cs = cs4[e2];
                const float l0 = bflo(klo[e2]), l1 = bfhi(klo[e2]), h0 = bflo(khi[e2]), h1 = bfhi(khi[e2]);
                lo[tt][e2] = pk2((l0 * cs.x - h0 * cs.y) * sc, (l1 * cs.z - h1 * cs.w) * sc);
                hi_[tt][e2] = pk2((h0 * cs.x + l0 * cs.y) * sc, (h1 * cs.z + l1 * cs.w) * sc); } }
#pragma unroll
        for (int e2 = 0; e2 < 4; ++e2) {
            u32x2 w;
            w.x = (lo[0][e2] & 0xffffu) | (lo[1][e2] << 16); w.y = (lo[2][e2] & 0xffffu) | (lo[3][e2] << 16); *(LAS u32x2*)(Kt + (8 * dc + 2 * e2) * 272 + tg * 8) = w;
            w.x = (lo[0][e2] >> 16) | (lo[1][e2] & 0xffff0000u); w.y = (lo[2][e2] >> 16) | (lo[3][e2] & 0xffff0000u); *(LAS u32x2*)(Kt + (8 * dc + 2 * e2 + 1) * 272 + tg * 8) = w;
            w.x = (hi_[0][e2] & 0xffffu) | (hi_[1][e2] << 16); w.y = (hi_[2][e2] & 0xffffu) | (hi_[3][e2] << 16); *(LAS u32x2*)(Kt + (64 + 8 * dc + 2 * e2) * 272 + tg * 8) = w;
            w.x = (hi_[0][e2] >> 16) | (hi_[1][e2] & 0xffff0000u); w.y = (hi_[2][e2] >> 16) | (hi_[3][e2] & 0xffff0000u); *(LAS u32x2*)(Kt + (64 + 8 * dc + 2 * e2 + 1) * 272 + tg * 8) = w;
        }
    } else {
        const int vt = C.tid - 256;
#pragma unroll
        for (int it = 0; it < 2; ++it) { const int item = vt + 256 * it, tg = item >> 4, dc = item & 15;
            u32x4 v[4];
#pragma unroll
            for (int tt = 0; tt < 4; ++tt) v[tt] = *(const u32x4*)(RV + (size_t)(t0 + 4 * tg + tt) * 512 + 128 * h + 8 * dc);
#pragma unroll
            for (int e2 = 0; e2 < 4; ++e2) { u32x2 w;
                w.x = (v[0][e2] & 0xffffu) | (v[1][e2] << 16); w.y = (v[2][e2] & 0xffffu) | (v[3][e2] << 16); *(LAS u32x2*)(Vt + (8 * dc + 2 * e2) * 272 + tg * 8) = w;
                w.x = (v[0][e2] >> 16) | (v[1][e2] & 0xffff0000u); w.y = (v[2][e2] >> 16) | (v[3][e2] & 0xffff0000u); *(LAS u32x2*)(Vt + (8 * dc + 2 * e2 + 1) * 272 + tg * 8) = w; } }
    }
    __syncthreads();
    const int r32 = C.lane & 31, hi = C.lane >> 5, dvb = C.wave >> 1, dkh = C.wave & 1;
    f32x16 acc0 = {}, acc1 = {};
#pragma unroll
    for (int ks = 0; ks < 8; ++ks) {
        const bf16x8 A = *(const LAS bf16x8*)(Vt + (32 * dvb + r32) * 272 + (16 * ks + 8 * hi) * 2);
        const bf16x8 B0 = *(const LAS bf16x8*)(Kt + (64 * dkh + r32) * 272 + (16 * ks + 8 * hi) * 2);
        const bf16x8 B1 = *(const LAS bf16x8*)(Kt + (64 * dkh + 32 + r32) * 272 + (16 * ks + 8 * hi) * 2);
        acc0 = __builtin_amdgcn_mfma_f32_32x32x16_bf16(A, B0, acc0, 0, 0, 0);
        acc1 = __builtin_amdgcn_mfma_f32_32x32x16_bf16(A, B1, acc1, 0, 0, 0);
    }
    float* dst = KV + ((size_t)(h * 128 + ck) * 128 + 32 * dvb) * 128 + 64 * dkh + r32;
#pragma unroll
    for (int r = 0; r < 16; ++r) { dst[(size_t)crow(r, hi) * 128] = acc0[r]; dst[(size_t)crow(r, hi) * 128 + 32] = acc1[r]; }
}

__device__ __forceinline__ void phase_p2a(const Ctx& C, const Args& a) {
    unsigned char* ws = a.ws;
    for (int u = blockIdx.x; u < 512; u += C.G) ret_kv_unit(C, a, u & 3, u >> 2);
    { const bf16* FQ = (const bf16*)(ws + WS_FQ); const bf16* FK = (const bf16*)(ws + WS_FQ + 16 * MiB); unsigned* ctl = (unsigned*)(ws + WS_CTL);
      const int gw = C.vcu * 8 + C.wave, NGW = C.G * 8; float mq = 0.f, mk = 0.f;
      for (int t = gw; t < M; t += NGW) {
          const u32x4 q = *(const u32x4*)(FQ + (size_t)t * 512 + 8 * C.lane), k = *(const u32x4*)(FK + (size_t)t * 512 + 8 * C.lane);
          float sq = 0.f, sk = 0.f;
#pragma unroll
          for (int e = 0; e < 4; ++e) { const float a0 = bflo(q[e]), a1 = bfhi(q[e]), b0 = bflo(k[e]), b1 = bfhi(k[e]); sq += a0 * a0 + a1 * a1; sk += b0 * b0 + b1 * b1; }
          sq += __shfl_xor(sq, 1); sq += __shfl_xor(sq, 2); sq += __shfl_xor(sq, 4);
          sk += __shfl_xor(sk, 1); sk += __shfl_xor(sk, 2); sk += __shfl_xor(sk, 4);
          mq = fmaxf(mq, sq); mk = fmaxf(mk, sk); }
      if ((C.lane & 7) == 0) { atomicMax(ctl + 32 + (C.lane >> 3), __float_as_uint(mq)); atomicMax(ctl + 48 + (C.lane >> 3), __float_as_uint(mk)); } }
    if ((int)blockIdx.x >= C.G - 8) {
        const int hh = C.G - 1 - (int)blockIdx.x;
        const float* lf = (const float*)(ws + WS_LOGF) + (size_t)hh * M + 32 * C.tid; double* cbo = (double*)(ws + WS_CB) + (size_t)hh * M + 32 * C.tid;
        f32x4 v[8];
#pragma unroll
        for (int i = 0; i < 8; ++i) v[i] = ((const f32x4*)lf)[i];
        double s = 0.0;
#pragma unroll
        for (int i = 0; i < 8; ++i) s += ((double)v[i].x + (double)v[i].y) + ((double)v[i].z + (double)v[i].w);
        double inc = s;
#pragma unroll
        for (int o = 1; o < 64; o <<= 1) { const double nb = __shfl_up(inc, o); if (C.lane >= o) inc += nb; }
        LAS double* wt = (LAS double*)C.L;
        __syncthreads();
        if (C.lane == 63) wt[C.wave] = inc;
        __syncthreads();
        double run = inc - s;
        for (int w2 = 0; w2 < C.wave; ++w2) run += wt[w2];
#pragma unroll
        for (int i = 0; i < 8; ++i) {
            run += (double)v[i].x; cbo[4 * i] = -run * 1.4426950408889634; run += (double)v[i].y; cbo[4 * i + 1] = -run * 1.4426950408889634;
            run += (double)v[i].z; cbo[4 * i + 2] = -run * 1.4426950408889634; run += (double)v[i].w; cbo[4 * i + 3] = -run * 1.4426950408889634; }
    }
}

__device__ __forceinline__ void phase_p2b(const Ctx& C, const Args& a) {
    unsigned char* ws = a.ws; const float* KV = (const float*)(ws + WS_KV); bf16* RT = (bf16*)(ws + WS_RT);
    const int e = (int)blockIdx.x * 512 + C.tid;
    if (e < 65536) {
        const int h = e >> 14, idx = e & 16383; const float g = exp2f(128.f * lg2gamma(h));
        float r = 0.f;
        for (int i0 = 0; i0 < 128; i0 += 32) {
            float v[32];
#pragma unroll
            for (int j = 0; j < 32; ++j) v[j] = KV[((size_t)(h * 128 + i0 + j) << 14) + idx];
#pragma unroll
            for (int j = 0; j < 32; ++j) { r = g * r + v[j]; RT[((size_t)(h * 128 + i0 + j) << 14) + idx] = (bf16)(pk2(r, 0.f) & 0xffffu); }
        }
    }
}

__device__ __forceinline__ void ret_out_unit(const Ctx& C, const Args& a, int h, int ck) {
    unsigned char* ws = a.ws;
    const bf16* RQ = (const bf16*)(ws + WS_FQ + 3 * 16 * MiB); const bf16* RK = (const bf16*)(ws + WS_FQ + 4 * 16 * MiB);
    const bf16* RV = (const bf16*)(ws + WS_FQ + 5 * 16 * MiB); const bf16* RG = (const bf16*)(ws + WS_FQ + 6 * 16 * MiB);
    const bf16* RT = (const bf16*)(ws + WS_RT); const f32x2* CS = (const f32x2*)(ws + WS_CS); bf16* ATT = (bf16*)(ws + WS_ATT);
    LAS unsigned char* Qs = C.L; LAS unsigned char* Ks = C.L + 34816; LAS unsigned char* Vt = C.L + 69632; LAS unsigned char* Rs = C.L + 104448; LAS f32x2* ST = (LAS f32x2*)(C.L + 139264);
    const int t0 = 128 * ck; const float lg = lg2gamma(h);
    __syncthreads();
#pragma unroll
    for (int it = 0; it < 2; ++it) { const int item = C.tid + 512 * it, m = item >> 3, dc = item & 7, t = t0 + m;
        const u32x4 qlo = *(const u32x4*)(RQ + (size_t)t * 512 + 128 * h + 8 * dc), qhi = *(const u32x4*)(RQ + (size_t)t * 512 + 128 * h + 64 + 8 * dc);
        const u32x4 klo = *(const u32x4*)(RK + (size_t)t * 512 + 128 * h + 8 * dc), khi = *(const u32x4*)(RK + (size_t)t * 512 + 128 * h + 64 + 8 * dc);
        const f32x4* cs4 = (const f32x4*)(CS + (size_t)t * 64 + 8 * dc);
        u32x4 oql, oqh, okl, okh; const float ksc = 0.08838834764831845f;
#pragma unroll
        for (int e2 = 0; e2 < 4; ++e2) { const f32x4 cs = cs4[e2];
            { const float l0 = bflo(qlo[e2]), l1 = bfhi(qlo[e2]), h0 = bflo(qhi[e2]), h1 = bfhi(qhi[e2]);
              oql[e2] = pk2(l0 * cs.x - h0 * cs.y, l1 * cs.z - h1 * cs.w); oqh[e2] = pk2(h0 * cs.x + l0 * cs.y, h1 * cs.z + l1 * cs.w); }
            { const float l0 = bflo(klo[e2]), l1 = bfhi(klo[e2]), h0 = bflo(khi[e2]), h1 = bfhi(khi[e2]);
              okl[e2] = pk2((l0 * cs.x - h0 * cs.y) * ksc, (l1 * cs.z - h1 * cs.w) * ksc); okh[e2] = pk2((h0 * cs.x + l0 * cs.y) * ksc, (h1 * cs.z + l1 * cs.w) * ksc); } }
        *(LAS u32x4*)(Qs + m * 272 + dc * 16) = oql; *(LAS u32x4*)(Qs + m * 272 + 128 + dc * 16) = oqh;
        *(LAS u32x4*)(Ks + m * 272 + dc * 16) = okl; *(LAS u32x4*)(Ks + m * 272 + 128 + dc * 16) = okh; }
    { const int tg = C.tid >> 4, dc = C.tid & 15; u32x4 v[4];
#pragma unroll
      for (int tt = 0; tt < 4; ++tt) v[tt] = *(const u32x4*)(RV + (size_t)(t0 + 4 * tg + tt) * 512 + 128 * h + 8 * dc);
      const int pos = kvpos(4 * tg);
#pragma unroll
      for (int e2 = 0; e2 < 4; ++e2) { u32x2 w;
          w.x = (v[0][e2] & 0xffffu) | (v[1][e2] << 16); w.y = (v[2][e2] & 0xffffu) | (v[3][e2] << 16); *(LAS u32x2*)(Vt + (8 * dc + 2 * e2) * 272 + pos * 2) = w;
          w.x = (v[0][e2] >> 16) | (v[1][e2] & 0xffff0000u); w.y = (v[2][e2] >> 16) | (v[3][e2] & 0xffff0000u); *(LAS u32x2*)(Vt + (8 * dc + 2 * e2 + 1) * 272 + pos * 2) = w; } }
#pragma unroll
    for (int it = 0; it < 4; ++it) { const int item = C.tid + 512 * it, dv = item >> 4, c16 = item & 15;
        u32x4 v = (u32x4){0u, 0u, 0u, 0u};
        if (ck > 0) v = *(const u32x4*)(RT + ((size_t)(h * 128 + ck - 1) << 14) + dv * 128 + 8 * c16);
        *(LAS u32x4*)(Rs + dv * 272 + c16 * 16) = v; }
    __syncthreads();
    const int r32 = C.lane & 31, hi = C.lane >> 5, nb = C.wave & 3, dh = C.wave >> 2;
    bf16x8 qf[8];
#pragma unroll
    for (int ks = 0; ks < 8; ++ks) qf[ks] = *(const LAS bf16x8*)(Qs + (32 * nb + r32) * 272 + (16 * ks + 8 * hi) * 2);
    f32x16 o0 = {}, o1 = {};
    const int n = 32 * nb + r32;
#pragma unroll
    for (int mb = 0; mb < 4; ++mb) {
        if (mb <= nb) {
            f32x16 p = {};
#pragma unroll
            for (int ks = 0; ks < 8; ++ks) { const bf16x8 A = *(const LAS bf16x8*)(Ks + (32 * mb + r32) * 272 + (16 * ks + 8 * hi) * 2); p = __builtin_amdgcn_mfma_f32_32x32x16_bf16(A, qf[ks], p, 0, 0, 0); }
#pragma unroll
            for (int r = 0; r < 16; ++r) { const int dl = n - (32 * mb + crow(r, hi)); p[r] = dl >= 0 ? p[r] * exp2f((float)dl * lg) : 0.f; }
#pragma unroll
            for (int half = 0; half < 2; ++half) {
                u32x4 pw; pw.x = pk2(p[8 * half + 0], p[8 * half + 1]); pw.y = pk2(p[8 * half + 2], p[8 * half + 3]); pw.z = pk2(p[8 * half + 4], p[8 * half + 5]); pw.w = pk2(p[8 * half + 6], p[8 * half + 7]);
                const bf16x8 B = __builtin_bit_cast(bf16x8, pw); const int ks2 = 2 * mb + half;
                const bf16x8 A0 = *(const LAS bf16x8*)(Vt + (64 * dh + r32) * 272 + (16 * ks2 + 8 * hi) * 2);
                const bf16x8 A1 = *(const LAS bf16x8*)(Vt + (64 * dh + 32 + r32) * 272 + (16 * ks2 + 8 * hi) * 2);
                o0 = __builtin_amdgcn_mfma_f32_32x32x16_bf16(A0, B, o0, 0, 0, 0); o1 = __builtin_amdgcn_mfma_f32_32x32x16_bf16(A1, B, o1, 0, 0, 0);
            }
        }
    }
    f32x16 c0 = {}, c1 = {};
#pragma unroll
    for (int ks = 0; ks < 8; ++ks) {
        const bf16x8 A0 = *(const LAS bf16x8*)(Rs + (64 * dh + r32) * 272 + (16 * ks + 8 * hi) * 2);
        const bf16x8 A1 = *(const LAS bf16x8*)(Rs + (64 * dh + 32 + r32) * 272 + (16 * ks + 8 * hi) * 2);
        c0 = __builtin_amdgcn_mfma_f32_32x32x16_bf16(A0, qf[ks], c0, 0, 0, 0); c1 = __builtin_amdgcn_mfma_f32_32x32x16_bf16(A1, qf[ks], c1, 0, 0, 0);
    }
    const float xi = exp2f((float)(n + 1) * lg);
    float s1 = 0.f, s2 = 0.f;
#pragma unroll
    for (int r = 0; r < 16; ++r) { o0[r] += c0[r] * xi; o1[r] += c1[r] * xi; s1 += o0[r] + o1[r]; s2 += o0[r] * o0[r] + o1[r] * o1[r]; }
    s1 += __shfl_xor(s1, 32); s2 += __shfl_xor(s2, 32);
    if (hi == 0) ST[C.wave * 32 + r32] = (f32x2){s1, s2};
    __syncthreads();
    { const f32x2 pr = ST[(C.wave ^ 4) * 32 + r32]; s1 += pr.x; s2 += pr.y; }
    const float mu = s1 * (1.f / 128.f), var = fmaxf(s2 * (1.f / 128.f) - mu * mu, 0.f), rstd = 1.0f / sqrtf(var + GN_EPS);
    const size_t trow = (size_t)(t0 + n);
#pragma unroll
    for (int db = 0; db < 2; ++db)
#pragma unroll
        for (int j = 0; j < 4; ++j) { const int dv = 64 * dh + 32 * db + 8 * j + 4 * hi;
            const u32x2 gw2 = *(const u32x2*)(RG + trow * 512 + 128 * h + dv);
            const float g0 = bflo(gw2.x), g1 = bfhi(gw2.x), g2 = bflo(gw2.y), g3 = bfhi(gw2.y);
            const f32x16& oo = db ? o1 : o0;
            const float v0 = (oo[4 * j] - mu) * rstd * (g0 / (1.f + __expf(-g0))), v1 = (oo[4 * j + 1] - mu) * rstd * (g1 / (1.f + __expf(-g1)));
            const float v2 = (oo[4 * j + 2] - mu) * rstd * (g2 / (1.f + __expf(-g2))), v3 = (oo[4 * j + 3] - mu) * rstd * (g3 / (1.f + __expf(-g3)));
            u32x2 w; w.x = pk2(v0, v1); w.y = pk2(v2, v3); *(u32x2*)(ATT + trow * 1024 + 512 + 128 * h + dv) = w; }
}

__device__ __forceinline__ void fox_unit(const Ctx& C, const Args& a, int h, int qb) {
    unsigned char* ws = a.ws;
    const bf16* FQ = (const bf16*)(ws + WS_FQ); const bf16* FK = (const bf16*)(ws + WS_FQ + 16 * MiB); const bf16* FV = (const bf16*)(ws + WS_FQ + 32 * MiB);
    const double* cb = (const double*)(ws + WS_CB) + (size_t)h * M; bf16* ATT = (bf16*)(ws + WS_ATT); const unsigned* ctl = (const unsigned*)(ws + WS_CTL);
    LAS unsigned char* Ks = C.L; LAS unsigned char* Vt = C.L + 9216; LAS float* Bs = (LAS float*)(C.L + 18432);
    const int tid = C.tid, lane = C.lane, r32 = lane & 31, hi = lane >> 5, w = C.wave, q0 = 256 * qb;
    const float G2 = sqrtf(__uint_as_float(ctl[32 + h]) * __uint_as_float(ctl[48 + h]));
    const float thr2 = -(152.0f + 2.0f * G2 * 1.001f);
    bf16x8 qr[4];
    { const bf16* qp = FQ + (size_t)(q0 + 32 * w + r32) * 512 + 64 * h + 8 * hi;
#pragma unroll
      for (int d0 = 0; d0 < 4; ++d0) qr[d0] = *(const bf16x8*)(qp + 16 * d0); }
    const double cref = cb[q0];
    int t_lo = 0;
    { int tb = 4 * qb - 1;
      while (tb >= 0) { const int t = tb - lane; bool skip = false;
          if (t >= 0) { const float D2 = (float)(cb[64 * t + 63] - cref); skip = D2 < thr2; }
          const unsigned long long bal = __ballot(skip);
          if (bal) { t_lo = tb - (__ffsll((long long)bal) - 1) + 1; break; }
          tb -= 64; } }
    t_lo = __builtin_amdgcn_readfirstlane(t_lo);
    const int jd = (q0 + 32 * w) >> 6;
    float m_run = -1e30f, l_run = 0.f; f32x16 o0 = {}, o1 = {};
    u32x4 kreg, vreg[4]; double breg = 0.0;
    const int krow = tid >> 3, kch = tid & 7, vtg = (tid >> 3) & 15;
#define FOX_ISSUE(t_) do { kreg = *(const u32x4*)(FK + (size_t)(64 * (t_) + krow) * 512 + 64 * h + 8 * kch); \
        if (tid < 128) { _Pragma("unroll") for (int tt = 0; tt < 4; ++tt) vreg[tt] = *(const u32x4*)(FV + (size_t)(64 * (t_) + 4 * vtg + tt) * 512 + 64 * h + 8 * kch); } \
        else if (tid < 192) breg = cb[64 * (t_) + tid - 128]; } while (0)
    int t = 4 * qb + 3;
    FOX_ISSUE(t);
    for (;;) {
        __syncthreads();
        *(LAS u32x4*)(Ks + krow * 144 + kch * 16) = kreg;
        if (tid < 128) { const int pos = kvpos(4 * vtg);
#pragma unroll
            for (int e2 = 0; e2 < 4; ++e2) { u32x2 ww;
                ww.x = (vreg[0][e2] & 0xffffu) | (vreg[1][e2] << 16); ww.y = (vreg[2][e2] & 0xffffu) | (vreg[3][e2] << 16); *(LAS u32x2*)(Vt + (8 * kch + 2 * e2) * 144 + pos * 2) = ww;
                ww.x = (vreg[0][e2] >> 16) | (vreg[1][e2] & 0xffff0000u); ww.y = (vreg[2][e2] >> 16) | (vreg[3][e2] & 0xffff0000u); *(LAS u32x2*)(Vt + (8 * kch + 2 * e2 + 1) * 144 + pos * 2) = ww; } }
        else if (tid < 192) Bs[tid - 128] = (float)(breg - cref);
        __syncthreads();
        const int tn = t - 1; const bool more = tn >= t_lo;
        if (more) FOX_ISSUE(tn);
        if (t <= jd) {
            f32x16 p0, p1;
#pragma unroll
            for (int j = 0; j < 4; ++j) { const f32x4 b0 = *(const LAS f32x4*)(Bs + 8 * j + 4 * hi), b1 = *(const LAS f32x4*)(Bs + 32 + 8 * j + 4 * hi);
                p0[4 * j] = b0.x; p0[4 * j + 1] = b0.y; p0[4 * j + 2] = b0.z; p0[4 * j + 3] = b0.w; p1[4 * j] = b1.x; p1[4 * j + 1] = b1.y; p1[4 * j + 2] = b1.z; p1[4 * j + 3] = b1.w; }
#pragma unroll
            for (int d0 = 0; d0 < 4; ++d0) { const bf16x8 a0 = *(const LAS bf16x8*)(Ks + r32 * 144 + (16 * d0 + 8 * hi) * 2), a1 = *(const LAS bf16x8*)(Ks + (32 + r32) * 144 + (16 * d0 + 8 * hi) * 2);
                p0 = __builtin_amdgcn_mfma_f32_32x32x16_bf16(a0, qr[d0], p0, 0, 0, 0); p1 = __builtin_amdgcn_mfma_f32_32x32x16_bf16(a1, qr[d0], p1, 0, 0, 0); }
            if (t == jd) { const int qg = q0 + 32 * w + r32;
#pragma unroll
                for (int r = 0; r < 16; ++r) { const int kv = 64 * t + crow(r, hi); if (kv > qg) p0[r] = -1e30f; if (kv + 32 > qg) p1[r] = -1e30f; } }
            float mx = fmaxf(p0[0], p1[0]);
#pragma unroll
            for (int r = 1; r < 16; ++r) mx = fmaxf(mx, fmaxf(p0[r], p1[r]));
            mx = fmaxf(mx, __shfl_xor(mx, 32));
            const float m_new = fmaxf(m_run, mx), alpha = __builtin_amdgcn_exp2f(m_run - m_new);
            float sum = 0.f;
#pragma unroll
            for (int r = 0; r < 16; ++r) { p0[r] = __builtin_amdgcn_exp2f(p0[r] - m_new); p1[r] = __builtin_amdgcn_exp2f(p1[r] - m_new); sum += p0[r] + p1[r]; }
            l_run = l_run * alpha + sum; m_run = m_new;
#pragma unroll
            for (int r = 0; r < 16; ++r) { o0[r] *= alpha; o1[r] *= alpha; }
#pragma unroll
            for (int ks = 0; ks < 4; ++ks) {
                u32x4 pw;
                if (ks < 2) { pw.x = pk2(p0[8 * ks], p0[8 * ks + 1]); pw.y = pk2(p0[8 * ks + 2], p0[8 * ks + 3]); pw.z = pk2(p0[8 * ks + 4], p0[8 * ks + 5]); pw.w = pk2(p0[8 * ks + 6], p0[8 * ks + 7]); }
                else { const int k2 = ks - 2; pw.x = pk2(p1[8 * k2], p1[8 * k2 + 1]); pw.y = pk2(p1[8 * k2 + 2], p1[8 * k2 + 3]); pw.z = pk2(p1[8 * k2 + 4], p1[8 * k2 + 5]); pw.w = pk2(p1[8 * k2 + 6], p1[8 * k2 + 7]); }
                const bf16x8 B = __builtin_bit_cast(bf16x8, pw);
                const bf16x8 A0 = *(const LAS bf16x8*)(Vt + r32 * 144 + (16 * ks + 8 * hi) * 2), A1 = *(const LAS bf16x8*)(Vt + (32 + r32) * 144 + (16 * ks + 8 * hi) * 2);
                o0 = __builtin_amdgcn_mfma_f32_32x32x16_bf16(A0, B, o0, 0, 0, 0); o1 = __builtin_amdgcn_mfma_f32_32x32x16_bf16(A1, B, o1, 0, 0, 0);
            }
        }
        if (!more) break;
        t = tn;
    }
#undef FOX_ISSUE
    l_run += __shfl_xor(l_run, 32);
    const float inv = 1.0f / l_run;
    bf16* op = ATT + (size_t)(q0 + 32 * w + r32) * 1024 + 64 * h;
#pragma unroll
    for (int j = 0; j < 4; ++j) { u32x2 w0, w1;
        w0.x = pk2(o0[4 * j] * inv, o0[4 * j + 1] * inv); w0.y = pk2(o0[4 * j + 2] * inv, o0[4 * j + 3] * inv);
        w1.x = pk2(o1[4 * j] * inv, o1[4 * j + 1] * inv); w1.y = pk2(o1[4 * j + 2] * inv, o1[4 * j + 3] * inv);
        *(u32x2*)(op + 8 * j + 4 * hi) = w0; *(u32x2*)(op + 32 + 8 * j + 4 * hi) = w1; }
}

__device__ __forceinline__ void ln_pass(const Ctx& C, float* io, const float* g, const float* b, bf16* Hout, const float* sh, const float* sc) {
    const int gw = C.vcu * 8 + C.wave, NGW = C.G * 8;
    f32x4 gv[4], bv[4], shv[4], scv[4];
#pragma unroll
    for (int j = 0; j < 4; ++j) { gv[j] = ((const f32x4*)g)[64 * j + C.lane]; bv[j] = ((const f32x4*)b)[64 * j + C.lane];
        if (Hout) { shv[j] = ((const f32x4*)sh)[64 * j + C.lane]; scv[j] = ((const f32x4*)sc)[64 * j + C.lane] + 1.0f; } }
    for (int t = gw; t < M; t += NGW) {
        f32x4* xr = (f32x4*)(io + (size_t)t * D) + C.lane;
        f32x4 v[4]; float s = 0.f;
#pragma unroll
        for (int j = 0; j < 4; ++j) { v[j] = xr[64 * j]; s += (v[j].x + v[j].y) + (v[j].z + v[j].w); }
        const float mean = wave_sum(s) * (1.f / D); float s2 = 0.f;
#pragma unroll
        for (int j = 0; j < 4; ++j) { v[j] = v[j] - mean; s2 += (v[j].x * v[j].x + v[j].y * v[j].y) + (v[j].z * v[j].z + v[j].w * v[j].w); }
        const float rstd = 1.f / sqrtf(wave_sum(s2) * (1.f / D) + LN_EPS);
#pragma unroll
        for (int j = 0; j < 4; ++j) { const f32x4 y = v[j] * rstd * gv[j] + bv[j]; xr[64 * j] = y;
            if (Hout) { const f32x4 hh = y * scv[j] + shv[j]; ((unsigned long long*)(Hout + (size_t)t * D))[64 * j + C.lane] = (unsigned long long)pk2(hh.x, hh.y) | ((unsigned long long)pk2(hh.z, hh.w) << 32); } }
    }
}

__global__ void __launch_bounds__(512, 2) mk_fwd(Args args) {
    extern __shared__ __attribute__((aligned(16))) unsigned char lds[];
    Ctx C; C.L = (LAS unsigned char*)lds; C.tid = threadIdx.x; C.lane = C.tid & 63; C.wave = __builtin_amdgcn_readfirstlane(C.tid >> 6);
    C.G = gridDim.x; { const int bx = blockIdx.x; C.vcu = (C.G % 8 == 0) ? (bx % 8) * (C.G / 8) + bx / 8 : bx; }
    unsigned char* ws = args.ws;
    const int lo = args.ph_lo, hi = args.ph_hi;
#define IN(k) (lo <= (k) && (k) < hi)
#define SEAM(k) do { if (IN(k) && IN((k) + 1)) { xcd_barrier(bar); } } while (0)
    if (C.tid < 16) ((LAS unsigned*)(C.L + BARLDS_OFF))[C.tid] = 0u;
    __syncthreads();
    XcdBarrier bar = xcd_barrier_post((unsigned*)(ws + WS_CTL) + CW_BAR, (volatile LAS unsigned*)(C.L + BARLDS_OFF));
    if (lo < 0) cg::this_grid().sync();
    const float* MODF = (const float*)(ws + WS_MODF);
    bf16* H = (bf16*)(ws + WS_H) + 2 * D;

    if (IN(0)) { phase_p0a(C, args); if (PROBE_DUP & 1) { __syncthreads(); phase_p0a(C, args); } } SEAM(0);
    if (IN(1)) { phase_p0b(C, args); if (PROBE_DUP & 2) { __syncthreads(); phase_p0b(C, args); } } SEAM(1);
    if (IN(2)) {
        pg8::Gemm g{H, (const bf16*)(ws + WS_WIN), M, NPROJ, D, 256}; pg8::StaticOrder S; S.init(M, NPROJ, C.G, (int)blockIdx.x);
        pg8::EpiBf16<0> E{(bf16*)(ws + WS_FQ), 512, nullptr, 512, (size_t)(16 * MiB) / 2, C2};
        pg8::gemm_phase<pg8::EpiBf16<0>, pg8::StaticOrder, true, true>(C.L, g, S, E);
        if (PROBE_DUP & 4) { __syncthreads(); pg8::gemm_phase<pg8::EpiBf16<0>, pg8::StaticOrder, true, true>(C.L, g, S, E); }
    } SEAM(2);
    if (IN(3)) { phase_p2a(C, args); if (PROBE_DUP & 8) { __syncthreads(); phase_p2a(C, args); } } SEAM(3);
    if (IN(4)) { phase_p2b(C, args); if (PROBE_DUP & 16) { __syncthreads(); phase_p2b(C, args); } } SEAM(4);
    if (IN(5)) {
        for (int rep = 0; rep < ((PROBE_DUP & 32) ? 2 : 1); ++rep) for (int u = blockIdx.x; u < 512; u += C.G) fox_unit(C, args, u & 7, 63 - (u >> 3));
        for (int rep = 0; rep < ((PROBE_DUP & 64) ? 2 : 1); ++rep) for (int u = blockIdx.x; u < 512; u += C.G) ret_out_unit(C, args, u & 3, u >> 2);
    } SEAM(5);
    if (IN(6)) {
        pg8::Gemm g{(const bf16*)(ws + WS_ATT), (const bf16*)(ws + WS_WO), M, D, D, 256}; pg8::StaticOrder S; S.init(M, D, C.G, (int)blockIdx.x);
        EpiRes E{args.in[0], args.out, MODF + 2 * D, ALPHA_F};
        pg8::gemm_phase<EpiRes, pg8::StaticOrder, true, true>(C.L, g, S, E);
        if (PROBE_DUP & 128) { __syncthreads(); pg8::gemm_phase<EpiRes, pg8::StaticOrder, true, true>(C.L, g, S, E); }
    } SEAM(6);
    if (IN(7)) {
        if (blockIdx.x == 0) { for (int i = C.tid; i < 2 * D / 2; i += 512) ((unsigned*)(ws + WS_H))[i] = 0u; }
        ln_pass(C, args.out, args.in[7], args.in[8], H, MODF + 3 * D, MODF + 4 * D);
    } SEAM(7);
    if (IN(8)) {
        pg8::Gemm g{(const bf16*)(ws + WS_H), (const bf16*)(ws + WS_WUP), M, NUP, D, 254}; pg8::StaticOrder S; S.nM = 65; S.nN = NUP / 256; S.nwg = 65 * (NUP / 256); S.G = C.G; S.c = (int)blockIdx.x;
        EpiGeglu E{(bf16*)(ws + WS_ACT), args.in[10], args.in[11], C.L + XCH_OFF};
        pg8::gemm_phase<EpiGeglu, pg8::StaticOrder, true, true>(C.L, g, S, E);
        if (PROBE_DUP & 256) { __syncthreads(); pg8::gemm_phase<EpiGeglu, pg8::StaticOrder, true, true>(C.L, g, S, E); }
    } SEAM(8);
    if (IN(9)) {
        pg8::Gemm g{(const bf16*)(ws + WS_ACT), (const bf16*)(ws + WS_WDN), M, D, DFF, 256}; pg8::StaticOrder S; S.init(M, D, C.G, (int)blockIdx.x);
        EpiRes E{args.out, args.out, MODF + 5 * D, ALPHA_F};
        pg8::gemm_phase<EpiRes, pg8::StaticOrder, true, true>(C.L, g, S, E);
    } SEAM(9);
    if (IN(10)) { ln_pass(C, args.out, args.in[13], args.in[14], nullptr, nullptr, nullptr); }
#undef IN
#undef SEAM
}

extern "C" void kernel_launch(void* const* d_in, const int* in_sizes, int n_in, void* d_out, int out_size, void* d_ws, size_t ws_size, hipStream_t stream) {
    static int grid = 0;
    if (grid == 0) {
        if (n_in != 15 || out_size != M * D || ws_size < WS_END) { fprintf(stderr, "kernel_launch: unexpected shapes (n_in %d out %d ws %zu)\n", n_in, out_size, ws_size); grid = -1; return; }
        int dev = 0, cus = 0, per_cu = 0;
        (void)hipGetDevice(&dev); (void)hipDeviceGetAttribute(&cus, hipDeviceAttributeMultiprocessorCount, dev);
        (void)hipFuncSetAttribute((const void*)mk_fwd, hipFuncAttributeMaxDynamicSharedMemorySize, LDS_BYTES);
        (void)hipOccupancyMaxActiveBlocksPerMultiprocessor(&per_cu, (const void*)mk_fwd, 512, LDS_BYTES);
        (void)hipGetLastError();
        if (per_cu < 1) fprintf(stderr, "kernel_launch: occupancy query says %d blocks per CU\n", per_cu);
        grid = cus > 0 ? cus : 256;
    }
    if (grid < 0) return;
    (void)hipMemsetAsync((char*)d_ws + WS_CTL, 0, CTL_BYTES, stream);
    Args a{};
    for (int i = 0; i < 15; ++i) a.in[i] = (const float*)d_in[i];
    a.out = (float*)d_out; a.ws = (unsigned char*)d_ws;
#if MK_PER_PHASE
    for (int p = 0; p < NPH; ++p) { a.ph_lo = p; a.ph_hi = p + 1; hipLaunchKernelGGL(mk_fwd, dim3(grid), dim3(512), LDS_BYTES, stream, a); }
#else
    a.ph_lo = 0; a.ph_hi = NPH;
    void* kargs[] = {&a};
    hipError_t e = hipLaunchCooperativeKernel((const void*)mk_fwd, dim3(grid), dim3(512), kargs, LDS_BYTES, stream);
    if (e != hipSuccess) fprintf(stderr, "cooperative launch failed: %s (grid %d)\n", hipGetErrorString(e), grid);
#endif
}
```
